# Optimizing an MI355X kernel written in HIP

```python
import jax, jax.numpy as jnp
from jax import lax
import numpy as np

D_MODEL = 1024
BATCH = 8
SEQ = 2048
DEPTH = 1

N_META = 16
D_SSD = D_MODEL
D_CONF = D_MODEL
D_MIX = D_SSD + D_CONF
SSD_HEADDIM = 64
SSD_HEADS = D_SSD // SSD_HEADDIM
SSD_GROUPS = 4
SSD_HPG = SSD_HEADS // SSD_GROUPS
SSD_STATE = 128
SSD_CONV = 4
SSD_CHUNK = 128
D_XBC = D_SSD + 2 * SSD_GROUPS * SSD_STATE
CONF_KERNEL = 31
D_IN = D_SSD + D_XBC + SSD_HEADS + 2 * D_CONF
PEER_HEADS = 8
PEER_NKEYS = 128
PEER_EXPERTS = PEER_NKEYS * PEER_NKEYS
PEER_DKEY = 256
PEER_TOPK = 16
PEER_BLOCK = 256
EPS = 1e-5

kernel_name = "hymba_ssd_conformer_peer_block"


def rmsnorm(x, w):
    xf = x.astype(jnp.float32)
    y = xf * lax.rsqrt(jnp.mean(xf * xf, axis=-1, keepdims=True) + EPS)
    return (y * w.astype(jnp.float32)).astype(x.dtype)


def causal_depthwise_conv(x, w, b):
    k = w.shape[0]
    y = lax.conv_general_dilated(x, w[:, None, :].astype(x.dtype), window_strides=(1,),
                                 padding=[(k - 1, 0)],
                                 dimension_numbers=("NWC", "WIO", "NWC"),
                                 feature_group_count=x.shape[-1])
    return y + b.astype(x.dtype)


def segsum(a):
    t = a.shape[-1]
    cs = jnp.cumsum(a, axis=-1)
    diff = cs[..., :, None] - cs[..., None, :]
    mask = jnp.tril(jnp.ones((t, t), dtype=bool))
    return jnp.where(mask, diff, -jnp.inf)


def ssd_chunked(xh, dt, a_neg, bm, cm):
    b, lp = xh.shape[0], xh.shape[1]
    nc = lp // SSD_CHUNK
    xh = xh.reshape(b, nc, SSD_CHUNK, SSD_GROUPS, SSD_HPG, SSD_HEADDIM)
    dtc = dt.reshape(b, nc, SSD_CHUNK, SSD_GROUPS, SSD_HPG)
    xdt = xh * dtc[..., None]
    bm = bm.reshape(b, nc, SSD_CHUNK, SSD_GROUPS, SSD_STATE)
    cm = cm.reshape(b, nc, SSD_CHUNK, SSD_GROUPS, SSD_STATE)
    dta = jnp.moveaxis(dtc * a_neg.reshape(SSD_GROUPS, SSD_HPG), 2, -1)
    a_cs = jnp.cumsum(dta, axis=-1)
    lmat = jnp.exp(segsum(dta))
    cb = jnp.einsum("bclgn,bcsgn->bcgls", cm, bm)
    y_diag = jnp.einsum("bcgls,bcgrls,bcsgrp->bclgrp", cb, lmat, xdt)
    decay_states = jnp.exp(a_cs[..., -1:] - a_cs)
    states = jnp.einsum("bclgn,bcgrl,bclgrp->bcgrpn", bm, decay_states, xdt)
    chunk_decay = jnp.exp(a_cs[..., -1])

    def step(h, inp):
        s, d = inp
        return h * d[..., None, None] + s, h

    h0 = jnp.zeros((b, SSD_GROUPS, SSD_HPG, SSD_HEADDIM, SSD_STATE), states.dtype)
    _, prev = lax.scan(step, h0, (jnp.moveaxis(states, 1, 0), jnp.moveaxis(chunk_decay, 1, 0)))
    prev = jnp.moveaxis(prev, 0, 1)
    y_off = jnp.einsum("bclgn,bcgrpn,bcgrl->bclgrp", cm, prev, jnp.exp(a_cs))
    return (y_diag + y_off).reshape(b, lp, SSD_HEADS, SSD_HEADDIM)


def ssd_mixer(z, xbc, dt_raw, conv_w, conv_b, dt_bias, a_log, d_skip, norm_w):
    b, l = z.shape[0], z.shape[1]
    xbc = jax.nn.silu(causal_depthwise_conv(xbc, conv_w, conv_b))
    xs, bm, cm = jnp.split(xbc, [D_SSD, D_SSD + SSD_GROUPS * SSD_STATE], axis=-1)
    f32 = jnp.float32
    dt = jax.nn.softplus(dt_raw.astype(f32) + dt_bias.astype(f32))
    a_neg = -jnp.exp(a_log.astype(f32))
    xh = xs.astype(f32).reshape(b, l, SSD_HEADS, SSD_HEADDIM)
    bm = bm.astype(f32).reshape(b, l, SSD_GROUPS, SSD_STATE)
    cm = cm.astype(f32).reshape(b, l, SSD_GROUPS, SSD_STATE)
    pad = (-N_META) % SSD_CHUNK
    padw = lambda t: jnp.pad(t, [(0, 0), (pad, 0)] + [(0, 0)] * (t.ndim - 2))
    y = ssd_chunked(padw(xh), padw(dt), a_neg, padw(bm), padw(cm))[:, pad:]
    y = y + d_skip.astype(f32)[:, None] * xh
    y = y.reshape(b, l, D_SSD) * jax.nn.silu(z.astype(f32))
    yg = y.reshape(b, l, SSD_GROUPS, D_SSD // SSD_GROUPS)
    yg = yg * lax.rsqrt(jnp.mean(yg * yg, axis=-1, keepdims=True) + EPS)
    return (yg.reshape(b, l, D_SSD) * norm_w.astype(f32)).astype(z.dtype)


def conformer_conv(u, conv_w, conv_b, ln_g, ln_b):
    a, g = jnp.split(u, 2, axis=-1)
    h = causal_depthwise_conv(a * jax.nn.sigmoid(g), conv_w, conv_b)
    hf = h.astype(jnp.float32)
    mu = jnp.mean(hf, axis=-1, keepdims=True)
    var = jnp.mean(jnp.square(hf - mu), axis=-1, keepdims=True)
    hn = (hf - mu) * lax.rsqrt(var + EPS) * ln_g.astype(jnp.float32) + ln_b.astype(jnp.float32)
    return jax.nn.silu(hn).astype(u.dtype)


def peer_ffn(x, w_query, sub_keys_1, sub_keys_2, w_down, w_up):
    b, l, d = x.shape
    t = b * l
    xt = x.reshape(t, d)
    q = (xt @ w_query).reshape(t, PEER_HEADS, PEER_DKEY)
    q1, q2 = jnp.split(q, 2, axis=-1)
    s1 = jnp.einsum("thd,hkd->thk", q1, sub_keys_1).astype(jnp.float32)
    s2 = jnp.einsum("thd,hkd->thk", q2, sub_keys_2).astype(jnp.float32)
    v1, i1 = lax.top_k(s1, PEER_TOPK)
    v2, i2 = lax.top_k(s2, PEER_TOPK)
    cand = (v1[..., :, None] + v2[..., None, :]).reshape(t, PEER_HEADS, PEER_TOPK * PEER_TOPK)
    cand_idx = (i1[..., :, None] * PEER_NKEYS + i2[..., None, :]).reshape(t, PEER_HEADS, PEER_TOPK * PEER_TOPK)
    top_s, pos = lax.top_k(cand, PEER_TOPK)
    expert_idx = jnp.take_along_axis(cand_idx, pos, axis=-1)
    gate = jax.nn.softmax(top_s, axis=-1).astype(x.dtype)
    tp = -(-t // PEER_BLOCK) * PEER_BLOCK
    nb = tp // PEER_BLOCK
    xp = jnp.pad(xt, [(0, tp - t), (0, 0)]).reshape(nb, PEER_BLOCK, d)
    ip = jnp.pad(expert_idx, [(0, tp - t), (0, 0), (0, 0)]).reshape(nb, PEER_BLOCK, PEER_HEADS, PEER_TOPK)
    gp = jnp.pad(gate, [(0, tp - t), (0, 0), (0, 0)]).reshape(nb, PEER_BLOCK, PEER_HEADS, PEER_TOPK)

    def block(args):
        xb, ib, gb = args
        u = w_down[ib]
        act = jax.nn.gelu(jnp.einsum("td,thkd->thk", xb, u), approximate=False) * gb
        v = w_up[ib]
        return jnp.einsum("thk,thkd->td", act, v)

    y = lax.map(block, (xp, ip, gp))
    return y.reshape(tp, d)[:t].reshape(b, l, d)


def setup_inputs(seed: int = 0) -> dict:
    key = jax.random.key(seed)
    ks = jax.random.split(key, 24)
    nrm = lambda k, shape, s: jax.random.normal(k, shape, jnp.float32) * s
    L = DEPTH
    dt0 = jnp.exp(jax.random.uniform(ks[5], (L, SSD_HEADS), jnp.float32, np.log(1e-3), np.log(1e-1)))
    return {
        "x": nrm(ks[0], (BATCH, SEQ, D_MODEL), 1.0),
        "meta_tokens": nrm(ks[1], (N_META, D_MODEL), 1.0),
        "norm_mix_w": 1.0 + nrm(ks[2], (L, D_MODEL), 0.02),
        "w_in": nrm(ks[3], (L, D_MODEL, D_IN), D_MODEL ** -0.5),
        "ssd_conv_w": nrm(ks[4], (L, SSD_CONV, D_XBC), SSD_CONV ** -0.5),
        "ssd_conv_b": nrm(ks[6], (L, D_XBC), 0.01),
        "ssd_dt_bias": dt0 + jnp.log(-jnp.expm1(-dt0)),
        "ssd_A_log": jnp.log(jax.random.uniform(ks[7], (L, SSD_HEADS), jnp.float32, 1.0, 16.0)),
        "ssd_D": 1.0 + nrm(ks[8], (L, SSD_HEADS), 0.02),
        "ssd_norm_w": 1.0 + nrm(ks[9], (L, D_SSD), 0.02),
        "conf_conv_w": nrm(ks[10], (L, CONF_KERNEL, D_CONF), CONF_KERNEL ** -0.5),
        "conf_conv_b": nrm(ks[11], (L, D_CONF), 0.01),
        "conf_ln_g": 1.0 + nrm(ks[12], (L, D_CONF), 0.02),
        "conf_ln_b": nrm(ks[13], (L, D_CONF), 0.01),
        "w_out": nrm(ks[14], (L, D_MIX, D_MODEL), D_MIX ** -0.5),
        "norm_ffn_w": 1.0 + nrm(ks[15], (L, D_MODEL), 0.02),
        "peer_w_query": nrm(ks[16], (L, D_MODEL, PEER_HEADS * PEER_DKEY), D_MODEL ** -0.5),
        "peer_sub_keys_1": nrm(ks[17], (L, PEER_HEADS, PEER_NKEYS, PEER_DKEY // 2), (PEER_DKEY // 2) ** -0.5),
        "peer_sub_keys_2": nrm(ks[18], (L, PEER_HEADS, PEER_NKEYS, PEER_DKEY // 2), (PEER_DKEY // 2) ** -0.5),
        "peer_w_down": nrm(ks[19], (L, PEER_EXPERTS, D_MODEL), D_MODEL ** -0.5),
        "peer_w_up": nrm(ks[20], (L, PEER_EXPERTS, D_MODEL), 0.25),
        "norm_final_w": 1.0 + nrm(ks[21], (D_MODEL,), 0.02),
    }


def reference(x, meta_tokens, norm_mix_w, w_in, ssd_conv_w, ssd_conv_b, ssd_dt_bias, ssd_A_log, ssd_D,
              ssd_norm_w, conf_conv_w, conf_conv_b, conf_ln_g, conf_ln_b, w_out, norm_ffn_w,
              peer_w_query, peer_sub_keys_1, peer_sub_keys_2, peer_w_down, peer_w_up, norm_final_w):
    b = x.shape[0]
    meta = jnp.broadcast_to(meta_tokens.astype(x.dtype)[None], (b, N_META, D_MODEL))
    h = jnp.concatenate([meta, x], axis=1)
    for l in range(DEPTH):
        u = rmsnorm(h, norm_mix_w[l])
        proj = u @ w_in[l]
        z, xbc, dt_raw, conf_in = jnp.split(
            proj, [D_SSD, D_SSD + D_XBC, D_SSD + D_XBC + SSD_HEADS], axis=-1)
        y_ssd = ssd_mixer(z, xbc, dt_raw, ssd_conv_w[l], ssd_conv_b[l], ssd_dt_bias[l],
                          ssd_A_log[l], ssd_D[l], ssd_norm_w[l])
        y_conf = conformer_conv(conf_in, conf_conv_w[l], conf_conv_b[l], conf_ln_g[l], conf_ln_b[l])
        h = h + jnp.concatenate([y_ssd, y_conf], axis=-1) @ w_out[l]
        h = h + peer_ffn(rmsnorm(h, norm_ffn_w[l]), peer_w_query[l], peer_sub_keys_1[l],
                         peer_sub_keys_2[l], peer_w_down[l], peer_w_up[l])
    return rmsnorm(h, norm_final_w)[:, N_META:]
```

```cpp
#include <hip/hip_runtime.h>
#include <hip/hip_cooperative_groups.h>
#include <cstdio>
#include <cstdint>
namespace cg = cooperative_groups;

#define LAS __attribute__((address_space(3)))
typedef unsigned short bf16_t;
typedef short bf16x8 __attribute__((ext_vector_type(8)));
typedef float f32x4 __attribute__((ext_vector_type(4)));
typedef float f32x2 __attribute__((ext_vector_type(2)));
typedef float f32x16 __attribute__((ext_vector_type(16)));
typedef unsigned u32x4 __attribute__((ext_vector_type(4)));
typedef unsigned u32x2 __attribute__((ext_vector_type(2)));
typedef __bf16 bf2_t __attribute__((ext_vector_type(2)));

constexpr int NB = 8, SEQ = 2048, NMETA = 16, DM = 1024;
constexpr int T = NB * SEQ;
constexpr int R = T + NMETA;
constexpr int DIN = 5136;
constexpr int NPROJ = 5120;
constexpr int NTHREADS = 512;
constexpr float EPS = 1e-5f;
constexpr int LDS_BYTES = 135168;
constexpr float WD_SCALE = 64.f, WU_SCALE = 8.f;

constexpr size_t OFF_XC = 0;
constexpr size_t OFF_ST = 0;
constexpr size_t OFF_WD = 67108864;
constexpr size_t OFF_WU = OFF_WD + 16777216;
constexpr size_t OFF_H1 = 0;
constexpr size_t OFF_Z = 134349056;
constexpr size_t OFF_U = OFF_Z + 33554432;
constexpr size_t OFF_IDX = OFF_U;
constexpr size_t OFF_GATE = OFF_U + 4194304;
constexpr size_t OFF_WTIN = OFF_U + 33587200;
constexpr size_t OFF_WTOUT = OFF_WTIN + 10485760 + 65536;
constexpr size_t OFF_WTQ = OFF_WTOUT + 4194304;
constexpr size_t OFF_KEYS = OFF_WTQ + 4194304;
constexpr size_t OFF_DTRAW = OFF_KEYS + 524288;
constexpr size_t OFF_XBCM = OFF_DTRAW + 1049600;
constexpr size_t OFF_CDEC = OFF_XBCM + 65536;
constexpr size_t OFF_YSSD = OFF_CDEC + 8192;
constexpr size_t OFF_BAR = OFF_YSSD + 33554432;
constexpr size_t OFF_ROWSS = OFF_BAR + 4096;
constexpr size_t OFF_ACS = OFF_ROWSS + 1048576;
constexpr size_t WS_END = OFF_ACS + 512 * 4096;

struct Params {
    const float* x; const float* meta; const float* norm_mix_w; const float* w_in; const float* ssd_conv_w; const float* ssd_conv_b;
    const float* dt_bias; const float* A_log; const float* Dskip; const float* ssd_norm_w; const float* conf_w; const float* conf_b;
    const float* ln_g; const float* ln_b; const float* w_out; const float* norm_ffn_w; const float* w_query; const float* keys1; const float* keys2;
    const float* w_down; const float* w_up; const float* norm_final_w;
    float* out; unsigned char* ws; int ph_lo, ph_hi;
};

__device__ __forceinline__ unsigned cvt_pk_bf16(float lo, float hi) { const f32x2 v = {lo, hi}; return __builtin_bit_cast(unsigned, __builtin_convertvector(v, bf2_t)); }
__device__ __forceinline__ float bf_lo(unsigned u) { return __uint_as_float(u << 16); }
__device__ __forceinline__ float bf_hi(unsigned u) { return __uint_as_float(u & 0xffff0000u); }
#define DPP_ADD(v, ctrl) v += __int_as_float(__builtin_amdgcn_update_dpp(0, __float_as_int(v), ctrl, 0xf, 0xf, false))
__device__ __forceinline__ float wave_sum(float v) {
    DPP_ADD(v, 0xB1); DPP_ADD(v, 0x4E); DPP_ADD(v, 0x141); DPP_ADD(v, 0x140);
    v += __int_as_float(__builtin_amdgcn_ds_swizzle(__float_as_int(v), 0x401F));
    return __int_as_float(__builtin_amdgcn_readlane(__float_as_int(v), 0)) + __int_as_float(__builtin_amdgcn_readlane(__float_as_int(v), 32));
}
__device__ __forceinline__ int xor32i(int v, int lane) {
    (void)lane; return __shfl_xor(v, 32);
}
__device__ __forceinline__ float xor16f(float v) { return __int_as_float(__builtin_amdgcn_ds_swizzle(__float_as_int(v), 0x401F)); }
__device__ __forceinline__ int opaque_tid() { int t; asm volatile("v_mov_b32 %0, %1" : "=v"(t) : "v"((int)threadIdx.x)); return t; }
__device__ __forceinline__ float sigmoidf_(float v) { return __builtin_amdgcn_rcpf(1.f + __builtin_amdgcn_exp2f(v * -1.44269504f)); }
__device__ __forceinline__ float siluf_(float v) { return v * __builtin_amdgcn_rcpf(1.f + __builtin_amdgcn_exp2f(v * -1.44269504f)); }
__device__ __forceinline__ float softplusf_(float v) {
    const float e = __builtin_amdgcn_exp2f(fabsf(v) * -1.44269504f);
    const float l = e < 1e-3f ? e * (1.f - 0.5f * e) : __builtin_amdgcn_logf(1.f + e) * 0.69314718f;
    return fmaxf(v, 0.f) + l;
}
#define swz_xor(v, pat) __int_as_float(__builtin_amdgcn_ds_swizzle(__float_as_int(v), pat))
#define LDS_WAIT() asm volatile("s_waitcnt lgkmcnt(0)" ::: "memory")

namespace pg8 {
constexpr int BM = 256, BK = 64, HALF = 128, HTB = HALF * BK * 2, STAGE_BYTES = 8 * HTB, NXCD = 8, WGM = 8;
__device__ __forceinline__ int lds_byte(int r, int c) { const int st = (r >> 4) * 2 + (c >> 5), rr = r & 15, cc = c & 31, ob = rr * 64 + cc * 2; return st * 1024 + (ob ^ (((ob >> 9) & 1) << 5)); }
__device__ __forceinline__ void stage_rc(int b, int& Rr, int& C) { const int st = b / 1024, sb = b % 1024, swz = sb ^ (((sb >> 9) & 1) << 5); Rr = (st >> 1) * 16 + swz / 64; C = (st & 1) * 32 + (swz % 64) / 2; }
__device__ __forceinline__ int perm32(int rho) { const int n = rho >> 4, i = rho & 15; return 8 * (i >> 2) + 4 * n + (i & 3); }
struct Unit { int pm, pn; };
struct Gemm { const bf16_t* A0; const bf16_t* A1; const bf16_t* Bt; int M, N, K, lda, tsplit; };
struct StaticOrder {
    int nM, nN, nwg, G, c;
    __device__ void init(int M, int N, int G_, int c_) { nM = M / BM; nN = N / BM; nwg = nM * nN; G = G_; c = c_; }
    __device__ bool next(int i, Unit& u) const {
        const long L = (long)i * G + c; if (L >= nwg) return false;
        int wgid = (int)L; { const int q = nwg / NXCD, r = nwg % NXCD, xcd = wgid % NXCD, off = wgid / NXCD; wgid = (xcd < r ? xcd * (q + 1) : r * (q + 1) + (xcd - r) * q) + off; }
        const int nig = WGM * nN, gid = wgid / nig, fm = gid * WGM, gsz = (nM - fm) < WGM ? (nM - fm) : WGM;
        u.pm = fm + ((wgid % nig) % gsz); u.pn = (wgid % nig) / gsz; return true;
    }
};

template <class Epi>
__device__ __forceinline__ void gemm_phase(LAS unsigned char* lds, const Gemm g, const StaticOrder& S, const Epi& E) {
    const int tid = opaque_tid(), wid = __builtin_amdgcn_readfirstlane(tid >> 6), lane = tid & 63, wr = wid >> 2, wc = wid & 3, fr = lane & 15, fq = lane >> 4;
    const int K = g.K, nt = K / BK, lda = g.lda, tsplit = g.tsplit;
    unsigned voffA[2], voffB[2];
#pragma unroll
    for (int i = 0; i < 2; ++i) { int Rr, C; stage_rc(tid * 16 + i * 8192, Rr, C); const int Rb = Epi::PERM ? ((Rr & ~31) + perm32(Rr & 31)) : Rr;
        voffA[i] = (unsigned)(Rr * lda + C) * 2u; voffB[i] = (unsigned)(Rb * K + C) * 2u; }
    const size_t kstep = (size_t)(BK * 2);
    const size_t hstepA = (size_t)HALF * lda * 2, tstepA = 2 * hstepA;
    const size_t hstepB = (size_t)HALF * K * 2, tstepB = 2 * hstepB;
    const unsigned ldsw = (unsigned)wid * 1024u;
    const int aoff = lds_byte(wr * 64 + fr, fq * 8), boff = lds_byte(wc * 32 + fr, fq * 8);
#define PG8_SA(b, h) (((b) * 2 + (h)) * HTB)
#define PG8_SB(b, h) ((4 + (b) * 2 + (h)) * HTB)
#define PG8_STAGE(bufoff, gbase, voff) do { _Pragma("unroll") for (int _i = 0; _i < 2; ++_i) \
        __builtin_amdgcn_global_load_lds((const unsigned*)((const char*)(gbase) + (voff)[_i]), (LAS unsigned*)(lds + (bufoff) + ldsw + _i * 8192), 16, 0, 0); } while (0)
#define PG8_LDA(dst, b, h) do { _Pragma("unroll") for (int m = 0; m < 4; ++m) _Pragma("unroll") for (int k = 0; k < 2; ++k) dst[m][k] = *(const LAS bf16x8*)(lds + PG8_SA(b, h) + aoff + m * 2048 + k * 1024); } while (0)
#define PG8_LDB(dst, b, h) do { _Pragma("unroll") for (int n = 0; n < 2; ++n) _Pragma("unroll") for (int k = 0; k < 2; ++k) dst[n][k] = *(const LAS bf16x8*)(lds + PG8_SB(b, h) + boff + n * 2048 + k * 1024); } while (0)
#define PG8_MMA(ai, bj, At, Bt) do { __builtin_amdgcn_s_setprio(1); _Pragma("unroll") for (int m = 0; m < 4; ++m) _Pragma("unroll") for (int n = 0; n < 2; ++n) _Pragma("unroll") for (int k = 0; k < 2; ++k) \
        acc[ai][bj][m][n] = __builtin_amdgcn_mfma_f32_16x16x32_bf16(Bt[n][k], At[m][k], acc[ai][bj][m][n], 0, 0, 0); __builtin_amdgcn_s_setprio(0); } while (0)
#define PG8_WAIT_V(n) asm volatile("s_waitcnt vmcnt(" #n ")" ::: "memory")
#define PG8_WAIT_L(n) asm volatile("s_waitcnt lgkmcnt(" #n ")" ::: "memory")
#define PG8_BAR __builtin_amdgcn_s_barrier()
#define PG8_SCHED __builtin_amdgcn_sched_barrier(0)
#define PG8_KPTR(c0, c1, t) ((t) < tsplit ? (c0) + (size_t)(t) * kstep : (c1) + (size_t)((t) - tsplit) * kstep)
    Unit cur, nxt; int ui = 0;
    if (!S.next(0, cur)) return;
    f32x4 acc[2][2][4][2];
#pragma unroll
    for (int a = 0; a < 2; ++a)
#pragma unroll
        for (int b = 0; b < 2; ++b)
#pragma unroll
            for (int m = 0; m < 4; ++m)
#pragma unroll
                for (int n = 0; n < 2; ++n) acc[a][b][m][n] = (f32x4){0.f, 0.f, 0.f, 0.f};
    bf16x8 At[4][2], B0[2][2], B1[2][2];
    const char* cA = (const char*)g.A0 + (size_t)cur.pm * tstepA; const char* cA1 = (const char*)g.A1 + (size_t)cur.pm * tstepA;
    const char* cB = (const char*)g.Bt + (size_t)cur.pn * tstepB;
    PG8_STAGE(PG8_SB(0, 0), cB, voffB); PG8_STAGE(PG8_SA(0, 0), cA, voffA); PG8_STAGE(PG8_SB(0, 1), cB + hstepB, voffB); PG8_STAGE(PG8_SA(0, 1), cA + hstepA, voffA);
    if (wr == 1) PG8_BAR;
    PG8_WAIT_V(4); PG8_BAR;
    PG8_STAGE(PG8_SB(1, 0), cB + kstep, voffB); PG8_STAGE(PG8_SA(1, 0), cA + kstep, voffA); PG8_STAGE(PG8_SB(1, 1), cB + hstepB + kstep, voffB);
    PG8_WAIT_V(6); PG8_BAR;
    for (;;) {
        const bool has_next = S.next(ui + 1, nxt);
        const char* nA = has_next ? (const char*)g.A0 + (size_t)nxt.pm * tstepA : cA; const char* nA1 = has_next ? (const char*)g.A1 + (size_t)nxt.pm * tstepA : cA1;
        const char* nB = has_next ? (const char*)g.Bt + (size_t)nxt.pn * tstepB : cB;
        for (int t = 0; t < nt; t += 2) {
            const bool last = (t == nt - 2);
            const char* a1 = PG8_KPTR(cA, cA1, t + 1);
            const char* a2 = last ? nA : PG8_KPTR(cA, cA1, t + 2); const char* b2 = last ? nB : cB + (size_t)(t + 2) * kstep;
            const char* a3 = a2 + kstep; const char* b3 = b2 + kstep;
            PG8_LDB(B0, 0, 0); PG8_SCHED; PG8_LDA(At, 0, 0); PG8_STAGE(PG8_SA(1, 1), a1 + hstepA, voffA);
            PG8_WAIT_L(8); PG8_BAR; PG8_WAIT_L(0); PG8_MMA(0, 0, At, B0); PG8_BAR; PG8_SCHED;
            PG8_LDB(B1, 0, 1); PG8_STAGE(PG8_SB(0, 0), b2, voffB);
            PG8_BAR; PG8_WAIT_L(0); PG8_MMA(0, 1, At, B1); PG8_BAR;
            PG8_LDA(At, 0, 1); PG8_STAGE(PG8_SA(0, 0), a2, voffA);
            PG8_BAR; PG8_WAIT_L(0); PG8_MMA(1, 0, At, B0); PG8_BAR; PG8_SCHED;
            PG8_STAGE(PG8_SB(0, 1), b2 + hstepB, voffB);
            PG8_WAIT_V(6); PG8_BAR; PG8_MMA(1, 1, At, B1); PG8_BAR;
            PG8_LDB(B0, 1, 0); PG8_SCHED; PG8_LDA(At, 1, 0); PG8_STAGE(PG8_SA(0, 1), a2 + hstepA, voffA);
            PG8_WAIT_L(8); PG8_BAR; PG8_WAIT_L(0); PG8_MMA(0, 0, At, B0); PG8_BAR; PG8_SCHED;
            PG8_LDB(B1, 1, 1); PG8_STAGE(PG8_SB(1, 0), b3, voffB);
            PG8_BAR; PG8_WAIT_L(0); PG8_MMA(0, 1, At, B1); PG8_BAR;
            PG8_LDA(At, 1, 1); PG8_STAGE(PG8_SA(1, 0), a3, voffA);
            PG8_BAR; PG8_WAIT_L(0); PG8_MMA(1, 0, At, B0); PG8_BAR; PG8_SCHED;
            PG8_STAGE(PG8_SB(1, 1), b3 + hstepB, voffB);
            PG8_WAIT_V(6); PG8_BAR; PG8_MMA(1, 1, At, B1); PG8_BAR;
        }
        E(acc, cur, wr, wc, fr, fq);
        if (!has_next) break;
#pragma unroll
        for (int a = 0; a < 2; ++a)
#pragma unroll
            for (int b = 0; b < 2; ++b)
#pragma unroll
                for (int m = 0; m < 4; ++m)
#pragma unroll
                    for (int n = 0; n < 2; ++n) acc[a][b][m][n] = (f32x4){0.f, 0.f, 0.f, 0.f};
        cur = nxt; cA = nA; cA1 = nA1; cB = nB; ++ui;
    }
    PG8_WAIT_V(0);
    if (wr == 0) PG8_BAR;
    PG8_BAR;
#undef PG8_SA
#undef PG8_SB
#undef PG8_STAGE
#undef PG8_LDA
#undef PG8_LDB
#undef PG8_MMA
#undef PG8_WAIT_V
#undef PG8_WAIT_L
#undef PG8_BAR
#undef PG8_SCHED
#undef PG8_KPTR
}

struct EpiProj {
    static constexpr bool PERM = true;
    bf16_t* O0; int ld0; bf16_t* O1; int ld1; int rowoff1; int csplit; const float* rowss;
    __device__ __forceinline__ void operator()(const f32x4 (&acc)[2][2][4][2], const Unit& u, int wr, int wc, int fr, int fq) const {
        int row0 = u.pm * BM + wr * 64 + fr; int colt = u.pn * BM; bf16_t* base = O0; int ldc = ld0;
        if (colt >= csplit) { base = O1; ldc = ld1; colt -= csplit; row0 += rowoff1; }
        const int col0 = colt + wc * 32 + 8 * fq;
#pragma unroll
        for (int ai = 0; ai < 2; ++ai)
#pragma unroll
            for (int m = 0; m < 4; ++m) { bf16_t* rowp = base + (size_t)(row0 + ai * HALF + m * 16) * ldc + col0;
                float rsc = 1.f;
                if (rowss) { const f32x4* rp = (const f32x4*)(rowss + (size_t)(row0 + ai * HALF + m * 16) * 16); const f32x4 s0 = rp[0], s1 = rp[1], s2 = rp[2], s3 = rp[3];
                    const float tot = ((s0[0] + s0[1]) + (s0[2] + s0[3])) + ((s1[0] + s1[1]) + (s1[2] + s1[3])) + ((s2[0] + s2[1]) + (s2[2] + s2[3])) + ((s3[0] + s3[1]) + (s3[2] + s3[3]));
                    rsc = rsqrtf(tot * (1.f / 1024.f) + EPS); }
#pragma unroll
                for (int bj = 0; bj < 2; ++bj) { const f32x4 v0 = acc[ai][bj][m][0] * rsc, v1 = acc[ai][bj][m][1] * rsc;
                    u32x4 w; w.x = cvt_pk_bf16(v0[0], v0[1]); w.y = cvt_pk_bf16(v0[2], v0[3]); w.z = cvt_pk_bf16(v1[0], v1[1]); w.w = cvt_pk_bf16(v1[2], v1[3]);
                    *(u32x4*)(rowp + bj * HALF) = w; } }
    }
};
struct EpiRes {
    static constexpr bool PERM = false;
    float* C; const float* res; int ldc; bf16_t* HB; float* rowss;
    __device__ __forceinline__ void operator()(const f32x4 (&acc)[2][2][4][2], const Unit& u, int wr, int wc, int fr, int fq) const {
        const int row0 = u.pm * BM + wr * 64 + fr, col0 = u.pn * BM + wc * 32 + 4 * fq;
#pragma unroll
        for (int ai = 0; ai < 2; ++ai)
#pragma unroll
            for (int m = 0; m < 4; ++m) { const int row = row0 + ai * HALF + m * 16; const size_t ro = (size_t)row * ldc + col0; float ssq = 0.f;
#pragma unroll
                for (int bj = 0; bj < 2; ++bj)
#pragma unroll
                    for (int n = 0; n < 2; ++n) { const f32x4 rv = *(const f32x4*)(res + ro + bj * HALF + n * 16); const f32x4 v = acc[ai][bj][m][n] + rv;
                        *(f32x4*)(C + ro + bj * HALF + n * 16) = v;
                        u32x2 o; o.x = cvt_pk_bf16(v[0], v[1]); o.y = cvt_pk_bf16(v[2], v[3]); *(u32x2*)(HB + ro + bj * HALF + n * 16) = o;
                        ssq += v[0] * v[0] + v[1] * v[1] + v[2] * v[2] + v[3] * v[3]; }
                ssq += xor16f(ssq); ssq += __shfl_xor(ssq, 32);
                if (fq == 0) rowss[(size_t)row * 16 + 4 * u.pn + wc] = ssq; }
    }
};
}

__device__ __forceinline__ void transpose_item(const float* W, int ldw, int K, bf16_t* WT, int nblk, int item, int lane, LAS float* scr, bool is_win, const float* kscale = nullptr) {
    const int kb = item / nblk, nb = item % nblk, k0 = 64 * kb, n0 = 32 * nb;
    const int ns = (is_win && n0 == 5120) ? 3072 : n0 + ((is_win && n0 >= 3072) ? 16 : 0);
#pragma unroll 8
    for (int i = 0; i < 32; ++i) { const int kk = 2 * i + (lane >> 5); scr[kk * 33 + (lane & 31)] = W[(size_t)(k0 + kk) * ldw + ns + (lane & 31)] * (kscale ? kscale[k0 + kk] : 1.f); }
    LDS_WAIT();
    const int c = lane & 7;
#pragma unroll
    for (int j = 0; j < 4; ++j) { const int n = (lane >> 3) + 8 * j; const LAS float* s = scr + (8 * c) * 33 + n;
        u32x4 o; o.x = cvt_pk_bf16(s[0 * 33], s[1 * 33]); o.y = cvt_pk_bf16(s[2 * 33], s[3 * 33]); o.z = cvt_pk_bf16(s[4 * 33], s[5 * 33]); o.w = cvt_pk_bf16(s[6 * 33], s[7 * 33]);
        *(u32x4*)(WT + (size_t)(n0 + n) * K + k0 + 8 * c) = o; }
    LDS_WAIT();
}

__device__ __forceinline__ void phase0(const Params& p, LAS unsigned char* lds) {
    const int tid = opaque_tid(), lane = tid & 63, wave = tid >> 6;
    const int gw = blockIdx.x * 8 + wave, NGW = gridDim.x * 8;
    LAS float* scr = (LAS float*)(lds + wave * 8704);
    bf16_t* wtin = (bf16_t*)(p.ws + OFF_WTIN); bf16_t* wtout = (bf16_t*)(p.ws + OFF_WTOUT); bf16_t* wtq = (bf16_t*)(p.ws + OFF_WTQ);
    for (int it = gw; it < 4624; it += NGW) {
        if (it < 2576) transpose_item(p.w_in, DIN, 1024, wtin, 161, it, lane, scr, true);
        else if (it < 3600) transpose_item(p.w_out, 1024, 2048, wtout, 32, it - 2576, lane, scr, false);
        else transpose_item(p.w_query, 2048, 1024, wtq, 64, it - 3600, lane, scr, false, p.norm_ffn_w);
    }
    {
        bf16_t* keys = (bf16_t*)(p.ws + OFF_KEYS);
        const int gt = blockIdx.x * NTHREADS + tid, NGT = gridDim.x * NTHREADS;
        for (int c = gt; c < 65536; c += NGT) {
            const int half = c >> 15, e = (c & 32767) * 4, h = e >> 14;
            const f32x4 v = *(const f32x4*)((half ? p.keys2 : p.keys1) + e);
            u32x2 o; o.x = cvt_pk_bf16(v[0], v[1]); o.y = cvt_pk_bf16(v[2], v[3]);
            *(u32x2*)(keys + e + (h + half) * 16384) = o;
        }
    }
    bf16_t* U = (bf16_t*)(p.ws + OFF_U);
    f32x4 wv[4];
#pragma unroll
    for (int j = 0; j < 4; ++j) wv[j] = *(const f32x4*)(p.norm_mix_w + 4 * (lane + 64 * j));
    for (int r = gw; r < R; r += NGW) {
        const float* src = r < NMETA ? p.meta + (size_t)r * DM : p.x + (size_t)(r - NMETA) * DM;
        f32x4 v[4]; float ss = 0.f;
#pragma unroll
        for (int j = 0; j < 4; ++j) { v[j] = *(const f32x4*)(src + 4 * (lane + 64 * j)); ss += v[j][0] * v[j][0] + v[j][1] * v[j][1] + v[j][2] * v[j][2] + v[j][3] * v[j][3]; }
        ss = wave_sum(ss);
        const float rs = rsqrtf(ss * (1.f / DM) + EPS);
#pragma unroll
        for (int j = 0; j < 4; ++j) {
            v[j] = v[j] * rs * wv[j];
            u32x2 o; o.x = cvt_pk_bf16(v[j][0], v[j][1]); o.y = cvt_pk_bf16(v[j][2], v[j][3]);
            *(u32x2*)(U + (size_t)r * DM + 4 * (lane + 64 * j)) = o;
        }
    }
}

__device__ __forceinline__ void phase1_meta(const Params& p) {
    const int tid = opaque_tid(), lane = tid & 63, wave = tid >> 6;
    const int gw = blockIdx.x * 8 + wave, NGW = gridDim.x * 8;
    const bf16_t* U = (const bf16_t*)(p.ws + OFF_U); const bf16_t* wt = (const bf16_t*)(p.ws + OFF_WTIN); bf16_t* XC = (bf16_t*)(p.ws + OFF_XC);
    float* dtraw = (float*)(p.ws + OFF_DTRAW);
    for (int it = gw; it < 256 + R / 16; it += NGW) {
        const bool is_dt = it >= 256;
        const int n0 = is_dt ? 4096 : it * 16, m0 = is_dt ? (it - 256) * 16 : 0;
        f32x4 acc = {0.f, 0.f, 0.f, 0.f};
        const bf16_t* ap = U + (size_t)(m0 + (lane & 15)) * DM + 8 * (lane >> 4);
        const bf16_t* bp = wt + (size_t)(1024 + n0 + (lane & 15)) * DM + 8 * (lane >> 4);
#pragma unroll 8
        for (int ks = 0; ks < 32; ++ks) { const bf16x8 a = *(const bf16x8*)(ap + 32 * ks), b = *(const bf16x8*)(bp + 32 * ks);
            acc = __builtin_amdgcn_mfma_f32_16x16x32_bf16(b, a, acc, 0, 0, 0); }
        if (is_dt) *(f32x4*)(dtraw + (size_t)(m0 + (lane & 15)) * 16 + 4 * (lane >> 4)) = acc;
        else { u32x2 o; o.x = cvt_pk_bf16(acc[0], acc[1]); o.y = cvt_pk_bf16(acc[2], acc[3]);
            *(u32x2*)(XC + (size_t)(lane & 15) * 4096 + n0 + 4 * (lane >> 4)) = o; }
    }
}

__device__ __forceinline__ int rowidx(int b, int s) { return s >= 0 ? NMETA + b * SEQ + s : s + NMETA; }

__device__ __forceinline__ void phase2(const Params& p, LAS unsigned char* lds) {
    const int tid = opaque_tid(), lane = tid & 63, wave = tid >> 6;
    LAS float* red = (LAS float*)lds;
    LAS float* tot = red + 128;
    const bf16_t* XC = (const bf16_t*)(p.ws + OFF_XC);
    bf16_t* YCONF = (bf16_t*)(p.ws + OFF_U);
    bf16_t* XBCC = (bf16_t*)p.out;
    bf16_t* XBCM = (bf16_t*)(p.ws + OFF_XBCM);
    constexpr int TS = 8;
    for (int item = blockIdx.x; item < 256; item += gridDim.x) {
        const int b = item >> 5, s0 = (item & 31) * 64;
        {
            const int c0 = 2 * tid;
            LAS f32x2* wl = (LAS f32x2*)(lds + 1024) + tid;
#pragma unroll
            for (int k = 0; k < 31; ++k) wl[k * 512] = *(const f32x2*)(p.conf_w + k * 1024 + c0);
            const f32x2 cb = *(const f32x2*)(p.conf_b + c0), lg = *(const f32x2*)(p.ln_g + c0), lb = *(const f32x2*)(p.ln_b + c0);
            const bool b0 = lane & 1, b1 = lane & 2, b2 = lane & 4, b3 = lane & 8;
            const int sidx = (b0 ? 8 : 0) + (b1 ? 4 : 0) + (b2 ? 2 : 0) + (b3 ? 1 : 0);
            f32x2 win[30 + TS];
            unsigned ra[TS], rg[TS];
#define RAW_LOAD(step_) do { _Pragma("unroll") for (int _i = 0; _i < TS; ++_i) { int _s = s0 + (step_) * TS + _i; _s = _s < -NMETA ? -NMETA : _s; \
            const bf16_t* _rp = XC + (size_t)rowidx(b, _s) * 4096 + 2048 + c0; ra[_i] = *(const unsigned*)_rp; rg[_i] = *(const unsigned*)(_rp + 1024); } } while (0)
#pragma unroll
            for (int i = 0; i < 30; ++i) win[i] = (f32x2){0.f, 0.f};
            RAW_LOAD(-32 / TS);
#pragma unroll 1
            for (int step = -32 / TS; step < 64 / TS; ++step) {
#pragma unroll
                for (int i = 0; i < TS; ++i) { const bool ok = (s0 + step * TS + i) >= -NMETA;
                    win[30 + i] = ok ? (f32x2){bf_lo(ra[i]) * sigmoidf_(bf_lo(rg[i])), bf_hi(ra[i]) * sigmoidf_(bf_hi(rg[i]))} : (f32x2){0.f, 0.f}; }
                if (step + 1 < 64 / TS) RAW_LOAD(step + 1);
                if (step >= 0) {
                    f32x2 h[TS];
#pragma unroll
                    for (int i = 0; i < TS; ++i) h[i] = cb;
#pragma unroll
                    for (int k = 0; k < 31; ++k) { const f32x2 w = wl[k * 512];
#pragma unroll
                        for (int i = 0; i < TS; ++i) h[i] += w * win[i + k]; }
                    float st[16];
#pragma unroll
                    for (int i = 0; i < TS; ++i) { st[2 * i] = h[i][0] + h[i][1]; st[2 * i + 1] = h[i][0] * h[i][0] + h[i][1] * h[i][1]; }
                    float r8[8], r4[4], r2[2], r1;
#pragma unroll
                    for (int i = 0; i < 8; ++i) { const float send = b0 ? st[i] : st[i + 8], keep = b0 ? st[i + 8] : st[i];
                        r8[i] = keep + __int_as_float(__builtin_amdgcn_update_dpp(0, __float_as_int(send), 0xB1, 0xf, 0xf, false)); }
#pragma unroll
                    for (int i = 0; i < 4; ++i) { const float send = b1 ? r8[i] : r8[i + 4], keep = b1 ? r8[i + 4] : r8[i];
                        r4[i] = keep + __int_as_float(__builtin_amdgcn_update_dpp(0, __float_as_int(send), 0x4E, 0xf, 0xf, false)); }
#pragma unroll
                    for (int i = 0; i < 2; ++i) { const float send = b2 ? r4[i] : r4[i + 2], keep = b2 ? r4[i + 2] : r4[i]; r2[i] = keep + swz_xor(send, 0x101F); }
                    { const float send = b3 ? r2[0] : r2[1], keep = b3 ? r2[1] : r2[0]; r1 = keep + swz_xor(send, 0x201F); }
                    r1 += swz_xor(r1, 0x401F); r1 += __shfl_xor(r1, 32);
                    __syncthreads();
                    if (lane < 16) red[wave * 16 + sidx] = r1;
                    __syncthreads();
                    if (tid < 16) { float a = 0.f;
#pragma unroll
                        for (int w = 0; w < 8; ++w) a += red[w * 16 + tid];
                        tot[tid] = a; }
                    __syncthreads();
#pragma unroll
                    for (int i = 0; i < TS; ++i) {
                        const float mu = tot[2 * i] * (1.f / 1024.f), var = tot[2 * i + 1] * (1.f / 1024.f) - mu * mu, rstd = rsqrtf(var + EPS);
                        const float y0 = (h[i][0] - mu) * rstd * lg[0] + lb[0], y1 = (h[i][1] - mu) * rstd * lg[1] + lb[1];
                        const int t = b * SEQ + s0 + step * TS + i;
                        *(unsigned*)(YCONF + (size_t)t * DM + c0) = cvt_pk_bf16(siluf_(y0), siluf_(y1));
                    }
                }
#pragma unroll
                for (int i = 0; i < 30; ++i) win[i] = win[i + TS];
            }
#undef RAW_LOAD
        }
        {
            const int c = 4 * tid;
            f32x4 w4[4];
#pragma unroll
            for (int k = 0; k < 4; ++k) w4[k] = *(const f32x4*)(p.ssd_conv_w + k * 2048 + c);
            const f32x4 bb = *(const f32x4*)(p.ssd_conv_b + c);
#define X4_LOAD(dst, row_) do { const u32x2 _v = *(const u32x2*)(XC + (size_t)(row_) * 4096 + c); dst = (f32x4){bf_lo(_v.x), bf_hi(_v.x), bf_lo(_v.y), bf_hi(_v.y)}; } while (0)
            f32x4 x0, x1, x2, x3;
            X4_LOAD(x0, rowidx(b, s0 - 3)); X4_LOAD(x1, rowidx(b, s0 - 2)); X4_LOAD(x2, rowidx(b, s0 - 1));
#pragma unroll 1
            for (int i0 = 0; i0 < 64; i0 += 8) {
                u32x2 rw[8];
#pragma unroll
                for (int i = 0; i < 8; ++i) rw[i] = *(const u32x2*)(XC + (size_t)(NMETA + b * SEQ + s0 + i0 + i) * 4096 + c);
#pragma unroll
                for (int i = 0; i < 8; ++i) {
                    x3 = (f32x4){bf_lo(rw[i].x), bf_hi(rw[i].x), bf_lo(rw[i].y), bf_hi(rw[i].y)};
                    f32x4 a = bb + w4[0] * x0 + w4[1] * x1 + w4[2] * x2 + w4[3] * x3;
                    u32x2 o; o.x = cvt_pk_bf16(siluf_(a[0]), siluf_(a[1])); o.y = cvt_pk_bf16(siluf_(a[2]), siluf_(a[3]));
                    *(u32x2*)(XBCC + (size_t)(b * SEQ + s0 + i0 + i) * 2048 + c) = o;
                    x0 = x1; x1 = x2; x2 = x3;
                }
            }
            if (item == 0) {
                x0 = (f32x4){0.f, 0.f, 0.f, 0.f}; x1 = x0; x2 = x0;
#pragma unroll 4
                for (int l = 0; l < NMETA; ++l) {
                    X4_LOAD(x3, l);
                    f32x4 a = bb + w4[0] * x0 + w4[1] * x1 + w4[2] * x2 + w4[3] * x3;
                    u32x2 o; o.x = cvt_pk_bf16(siluf_(a[0]), siluf_(a[1])); o.y = cvt_pk_bf16(siluf_(a[2]), siluf_(a[3]));
                    *(u32x2*)(XBCM + (size_t)l * 2048 + c) = o;
                    x0 = x1; x1 = x2; x2 = x3;
                }
            }
#undef X4_LOAD
        }
    }
}

__device__ __forceinline__ bf16x8 tr_read8(unsigned base, const int off0, const int off1) {
    u32x2 lo, hi;
    asm volatile("ds_read_b64_tr_b16 %0, %2 offset:%3\n\tds_read_b64_tr_b16 %1, %2 offset:%4\n\ts_waitcnt lgkmcnt(0)" : "=&v"(lo), "=&v"(hi) : "v"(base), "i"(off0), "i"(off1) : "memory");
    u32x4 r; r.x = lo.x; r.y = lo.y; r.z = hi.x; r.w = hi.y;
    return __builtin_bit_cast(bf16x8, r);
}
__device__ __forceinline__ void ssd_dt_scan(const Params& p, LAS float* acs, LAS float* dtv, LAS float* wtot, int row0, int g) {
    const int tid = opaque_tid(), lane = tid & 63, wave = tid >> 6, r = tid >> 7, l = tid & 127, h = 4 * g + r;
    const float* dtraw = (const float*)(p.ws + OFF_DTRAW);
    const float dt = softplusf_(dtraw[(size_t)(row0 + l) * 16 + h] + p.dt_bias[h]);
    const float aneg = -__expf(p.A_log[h]);
    float v = dt * aneg;
#pragma unroll
    for (int o = 1; o < 64; o <<= 1) { const float n = __shfl_up(v, o); if (lane >= o) v += n; }
    if (lane == 63) wtot[wave] = v;
    __syncthreads();
    if (wave & 1) v += wtot[wave - 1];
    acs[r * 128 + l] = v; dtv[r * 128 + l] = dt;
    __syncthreads();
}

__device__ __forceinline__ void phase3(const Params& p, LAS unsigned char* lds) {
    const int tid = opaque_tid(), lane = tid & 63, wave = __builtin_amdgcn_readfirstlane(tid >> 6);
    LAS float* acs = (LAS float*)lds; LAS float* dtv = acs + 512; LAS float* wtot = dtv + 512;
    constexpr int XS_OFF = 4352, XS_STRIDE = 544, BS_OFF = XS_OFF + 128 * XS_STRIDE, BS_STRIDE = 288;
    const bf16_t* XBCC = (const bf16_t*)p.out;
    bf16_t* ST = (bf16_t*)(p.ws + OFF_ST); float* CDEC = (float*)(p.ws + OFF_CDEC);
    const unsigned lbase = (unsigned)(uintptr_t)lds;
    for (int item = blockIdx.x; item < 512; item += gridDim.x) {
        const int g = item & 3, c = (item >> 2) & 15, b = item >> 6;
        const int t0 = b * SEQ + c * 128;
        u32x4 xr[8], br[4];
#pragma unroll
        for (int ps = 0; ps < 8; ++ps) xr[ps] = *(const u32x4*)(XBCC + (size_t)(t0 + ps * 16 + (tid >> 5)) * 2048 + g * 256 + (tid & 31) * 8);
#pragma unroll
        for (int ps = 0; ps < 4; ++ps) br[ps] = *(const u32x4*)(XBCC + (size_t)(t0 + ps * 32 + (tid >> 4)) * 2048 + 1024 + g * 128 + (tid & 15) * 8);
        ssd_dt_scan(p, acs, dtv, wtot, NMETA + t0, g);
        { float* ap = (float*)(p.ws + OFF_ACS) + (size_t)item * 1024; ap[tid] = acs[tid]; ap[512 + tid] = dtv[tid]; }
        if (tid < 4) CDEC[(b * 16 + c) * 16 + 4 * g + tid] = __expf(acs[tid * 128 + 127]);
#pragma unroll
        for (int ps = 0; ps < 8; ++ps) {
            const int row = ps * 16 + (tid >> 5), ch = tid & 31, r = ch >> 3;
            const u32x4 v = xr[ps];
            const float sc = dtv[r * 128 + row] * __expf(acs[r * 128 + 127] - acs[r * 128 + row]);
            u32x4 o; o.x = cvt_pk_bf16(bf_lo(v.x) * sc, bf_hi(v.x) * sc); o.y = cvt_pk_bf16(bf_lo(v.y) * sc, bf_hi(v.y) * sc);
            o.z = cvt_pk_bf16(bf_lo(v.z) * sc, bf_hi(v.z) * sc); o.w = cvt_pk_bf16(bf_lo(v.w) * sc, bf_hi(v.w) * sc);
            *(LAS u32x4*)(lds + XS_OFF + row * XS_STRIDE + ch * 16) = o;
        }
#pragma unroll
        for (int ps = 0; ps < 4; ++ps) { const int row = ps * 32 + (tid >> 4), ch = tid & 15; *(LAS u32x4*)(lds + BS_OFF + row * BS_STRIDE + ch * 16) = br[ps]; }
        __syncthreads();
        f32x4 acc[4][4];
#pragma unroll
        for (int r = 0; r < 4; ++r)
#pragma unroll
            for (int mt = 0; mt < 4; ++mt) acc[r][mt] = (f32x4){0.f, 0.f, 0.f, 0.f};
        const int gid = lane >> 4, q = (lane & 15) >> 2, pp = lane & 3;
const unsigned bbase = lbase + BS_OFF + (8 * gid + q) * BS_STRIDE + (16 * wave + 4 * pp) * 2;
        const unsigned xbase = lbase + XS_OFF + (8 * gid + q) * XS_STRIDE + (4 * pp) * 2;
#pragma unroll
        for (int ks = 0; ks < 4; ++ks) {
            const bf16x8 bfrag = tr_read8(bbase, 32 * ks * BS_STRIDE, 32 * ks * BS_STRIDE + 4 * BS_STRIDE);
#pragma unroll
            for (int r = 0; r < 4; ++r)
#pragma unroll
                for (int mt = 0; mt < 4; ++mt) {
                    const bf16x8 xfrag = tr_read8(xbase, 32 * ks * XS_STRIDE + (r * 64 + 16 * mt) * 2, 32 * ks * XS_STRIDE + (r * 64 + 16 * mt) * 2 + 4 * XS_STRIDE);
                    acc[r][mt] = __builtin_amdgcn_mfma_f32_16x16x32_bf16(bfrag, xfrag, acc[r][mt], 0, 0, 0);
                }
        }
#pragma unroll
        for (int r = 0; r < 4; ++r)
#pragma unroll
            for (int mt = 0; mt < 4; ++mt)
                { u32x2 o; o.x = cvt_pk_bf16(acc[r][mt][0], acc[r][mt][1]); o.y = cvt_pk_bf16(acc[r][mt][2], acc[r][mt][3]);
                  *(u32x2*)(ST + ((size_t)((b * 16 + c) * 16 + 4 * g + r) * 64 + 16 * mt + (lane & 15)) * 128 + 16 * wave + 4 * (lane >> 4)) = o; }
        __syncthreads();
    }
}

__device__ __forceinline__ void phase4(const Params& p) {
    const int gt = blockIdx.x * NTHREADS + opaque_tid(), NGT = gridDim.x * NTHREADS;
    bf16_t* ST = (bf16_t*)(p.ws + OFF_ST); const float* CDEC = (const float*)(p.ws + OFF_CDEC);
    const bf16_t* XBCM = (const bf16_t*)(p.ws + OFF_XBCM); const float* dtraw = (const float*)(p.ws + OFF_DTRAW);
    for (int e = gt; e < NB * 16 * 64 * 32; e += NGT) {
        const int n4 = e & 31, pq = (e >> 5) & 63, h = (e >> 11) & 15, b = e >> 15, g = h >> 2;
        const float aneg = -__expf(p.A_log[h]), bias = p.dt_bias[h];
        f32x4 run = {0.f, 0.f, 0.f, 0.f}; float suf = 0.f;
        for (int l = NMETA - 1; l >= 0; --l) {
            const float dt = softplusf_(dtraw[l * 16 + h] + bias);
            const float w = dt * __expf(suf) * __uint_as_float((unsigned)XBCM[l * 2048 + h * 64 + pq] << 16);
            const u32x2 bv = *(const u32x2*)(XBCM + l * 2048 + 1024 + g * 128 + 4 * n4);
            run += w * (f32x4){bf_lo(bv.x), bf_hi(bv.x), bf_lo(bv.y), bf_hi(bv.y)};
            suf += dt * aneg;
        }
        bf16_t* sp = ST + ((size_t)(b * 16 * 16 + h) * 64 + pq) * 128 + 4 * n4;
        u32x2 sv[16];
#pragma unroll
        for (int c = 0; c < 16; ++c) sv[c] = *(const u32x2*)(sp + (size_t)c * 16 * 64 * 128);
#pragma unroll
        for (int c = 0; c < 16; ++c) {
            u32x2 o; o.x = cvt_pk_bf16(run[0], run[1]); o.y = cvt_pk_bf16(run[2], run[3]);
            *(u32x2*)(sp + (size_t)c * 16 * 64 * 128) = o;
            run = run * CDEC[(b * 16 + c) * 16 + h] + (f32x4){bf_lo(sv[c].x), bf_hi(sv[c].x), bf_lo(sv[c].y), bf_hi(sv[c].y)};
        }
    }
}

__device__ __forceinline__ void phase5(const Params& p, LAS unsigned char* lds) {
    const int tid = opaque_tid(), lane = tid & 63, wave = __builtin_amdgcn_readfirstlane(tid >> 6);
    LAS float* acs = (LAS float*)lds; LAS float* dtv = acs + 512; LAS float* wtot = dtv + 512;
    constexpr int TS = 288;
    constexpr int CS_OFF = 4352, BM_OFF = CS_OFF + 128 * TS, XS_OFF = BM_OFF + 128 * TS, XS_STRIDE = 144, PS_OFF = XS_OFF + 128 * XS_STRIDE;
    const bf16_t* XBCC = (const bf16_t*)p.out; const bf16_t* Z = (const bf16_t*)(p.ws + OFF_Z);
    const bf16_t* ST = (const bf16_t*)(p.ws + OFF_ST); bf16_t* YSSD = (bf16_t*)(p.ws + OFF_YSSD);
    const unsigned lbase = (unsigned)(uintptr_t)lds;
    const int fr = lane & 15, fq = lane >> 4;
    for (int item = blockIdx.x; item < 512; item += gridDim.x) {
        const int g = item & 3, c = (item >> 2) & 15, b = item >> 6;
        const int t0 = b * SEQ + c * 128;
        u32x4 brr[4], crr[4];
#pragma unroll
        for (int ps = 0; ps < 4; ++ps) { const bf16_t* rp = XBCC + (size_t)(t0 + ps * 32 + (tid >> 4)) * 2048 + 1024 + g * 128 + (tid & 15) * 8; brr[ps] = *(const u32x4*)rp; crr[ps] = *(const u32x4*)(rp + 512); }
        u32x4 xq[2], pq4[2];
#define P5_PREFETCH(r_) do { const int _h = 4 * g + (r_); _Pragma("unroll") for (int _ps = 0; _ps < 2; ++_ps) { \
            xq[_ps] = *(const u32x4*)(XBCC + (size_t)(t0 + _ps * 64 + (tid >> 3)) * 2048 + _h * 64 + (tid & 7) * 8); \
            const int _e = _ps * 512 + tid; pq4[_ps] = *(const u32x4*)(ST + ((size_t)((b * 16 + c) * 16 + _h) * 64 + (_e >> 4)) * 128 + 8 * (_e & 15)); } } while (0)
        P5_PREFETCH(0);
        { const float* ap = (const float*)(p.ws + OFF_ACS) + (size_t)item * 1024; acs[tid] = ap[tid]; dtv[tid] = ap[512 + tid]; }
#pragma unroll
        for (int ps = 0; ps < 4; ++ps) { const int row = ps * 32 + (tid >> 4), ch = tid & 15;
            *(LAS u32x4*)(lds + BM_OFF + row * TS + ch * 16) = brr[ps]; *(LAS u32x4*)(lds + CS_OFF + row * TS + ch * 16) = crr[ps]; }
        __syncthreads();
        f32x4 cb[8];
#pragma unroll
        for (int nt = 0; nt < 8; ++nt) cb[nt] = (f32x4){0.f, 0.f, 0.f, 0.f};
        bf16x8 cfrag[4];
#pragma unroll
        for (int ks = 0; ks < 4; ++ks) cfrag[ks] = *(const LAS bf16x8*)(lds + CS_OFF + (16 * wave + fr) * TS + (32 * ks + 8 * fq) * 2);
#pragma unroll
        for (int nt = 0; nt < 8; ++nt)
#pragma unroll
            for (int ks = 0; ks < 4; ++ks) { const bf16x8 bfrag = *(const LAS bf16x8*)(lds + BM_OFF + (16 * nt + fr) * TS + (32 * ks + 8 * fq) * 2);
                cb[nt] = __builtin_amdgcn_mfma_f32_16x16x32_bf16(bfrag, cfrag[ks], cb[nt], 0, 0, 0); }
        __syncthreads();
        f32x4 y[4][4];
        const int l = 16 * wave + fr;
#pragma unroll
        for (int r = 0; r < 4; ++r) {
            const int h = 4 * g + r;
            const float al = acs[r * 128 + l];
#pragma unroll
            for (int nt = 0; nt < 8; ++nt) { const int s = 16 * nt + 4 * fq; float m[4];
#pragma unroll
                for (int j = 0; j < 4; ++j) m[j] = (s + j <= l) ? cb[nt][j] * __expf(al - acs[r * 128 + s + j]) : 0.f;
                u32x2 o; o.x = cvt_pk_bf16(m[0], m[1]); o.y = cvt_pk_bf16(m[2], m[3]);
                *(LAS u32x2*)(lds + BM_OFF + l * TS + s * 2) = o; }
#pragma unroll
            for (int ps = 0; ps < 2; ++ps) { const int row = ps * 64 + (tid >> 3), ch = tid & 7;
                const u32x4 v = xq[ps]; const float sc = dtv[r * 128 + row];
                u32x4 o; o.x = cvt_pk_bf16(bf_lo(v.x) * sc, bf_hi(v.x) * sc); o.y = cvt_pk_bf16(bf_lo(v.y) * sc, bf_hi(v.y) * sc);
                o.z = cvt_pk_bf16(bf_lo(v.z) * sc, bf_hi(v.z) * sc); o.w = cvt_pk_bf16(bf_lo(v.w) * sc, bf_hi(v.w) * sc);
                *(LAS u32x4*)(lds + XS_OFF + row * XS_STRIDE + ch * 16) = o;
                const int e = ps * 512 + tid; *(LAS u32x4*)(lds + PS_OFF + (e >> 4) * TS + (e & 15) * 16) = pq4[ps]; }
            if (r < 3) P5_PREFETCH(r + 1);
            __syncthreads();
#pragma unroll
            for (int mt = 0; mt < 4; ++mt) { f32x4 a = {0.f, 0.f, 0.f, 0.f};
#pragma unroll
                for (int ks = 0; ks < 4; ++ks) { const bf16x8 pf = *(const LAS bf16x8*)(lds + PS_OFF + (16 * mt + fr) * TS + (32 * ks + 8 * fq) * 2);
                    a = __builtin_amdgcn_mfma_f32_16x16x32_bf16(pf, cfrag[ks], a, 0, 0, 0); }
                y[r][mt] = a * __expf(al); }
            {
                const int q = fr >> 2, pp = lane & 3;
                const unsigned xbase = lbase + XS_OFF + (8 * fq + q) * XS_STRIDE + (4 * pp) * 2;
#pragma unroll
                for (int ks = 0; ks < 4; ++ks) {
                    const bf16x8 mf = *(const LAS bf16x8*)(lds + BM_OFF + l * TS + (32 * ks + 8 * fq) * 2);
#pragma unroll
                    for (int mt = 0; mt < 4; ++mt) { const bf16x8 xf = tr_read8(xbase, 32 * ks * XS_STRIDE + 32 * mt, 32 * ks * XS_STRIDE + 32 * mt + 4 * XS_STRIDE);
                        y[r][mt] = __builtin_amdgcn_mfma_f32_16x16x32_bf16(xf, mf, y[r][mt], 0, 0, 0); }
                }
            }
            __syncthreads();
        }
#undef P5_PREFETCH
        const size_t t = (size_t)(t0 + l);
        float ss = 0.f;
#pragma unroll
        for (int r = 0; r < 4; ++r) { const float dsk = p.Dskip[4 * g + r];
#pragma unroll
            for (int mt = 0; mt < 4; ++mt) { const int ch = (4 * g + r) * 64 + 16 * mt + 4 * fq;
                const u32x2 xv = *(const u32x2*)(XBCC + t * 2048 + ch); const u32x2 zv = *(const u32x2*)(Z + t * DM + ch);
                f32x4 v = y[r][mt];
                v[0] = (v[0] + dsk * bf_lo(xv.x)) * siluf_(bf_lo(zv.x)); v[1] = (v[1] + dsk * bf_hi(xv.x)) * siluf_(bf_hi(zv.x));
                v[2] = (v[2] + dsk * bf_lo(xv.y)) * siluf_(bf_lo(zv.y)); v[3] = (v[3] + dsk * bf_hi(xv.y)) * siluf_(bf_hi(zv.y));
                ss += v[0] * v[0] + v[1] * v[1] + v[2] * v[2] + v[3] * v[3]; y[r][mt] = v; } }
        ss += xor16f(ss); ss += __int_as_float(xor32i(__float_as_int(ss), lane));
        const float rs = rsqrtf(ss * (1.f / 256.f) + EPS);
#pragma unroll
        for (int r = 0; r < 4; ++r)
#pragma unroll
            for (int mt = 0; mt < 4; ++mt) { const int ch = (4 * g + r) * 64 + 16 * mt + 4 * fq; const f32x4 nw = *(const f32x4*)(p.ssd_norm_w + ch); const f32x4 v = y[r][mt] * rs * nw;
                u32x2 o; o.x = cvt_pk_bf16(v[0], v[1]); o.y = cvt_pk_bf16(v[2], v[3]); *(u32x2*)(YSSD + t * DM + ch) = o; }
    }
}

__device__ __forceinline__ void phase7(const Params& p) {
    const int tid = opaque_tid(), lane = tid & 63, wave = tid >> 6;
    const int gw = blockIdx.x * 8 + wave, NGW = gridDim.x * 8;
    const float* H1 = (const float*)(p.ws + OFF_H1); bf16_t* U2 = (bf16_t*)(p.ws + OFF_Z);
    f32x4 wv[4];
#pragma unroll
    for (int j = 0; j < 4; ++j) wv[j] = *(const f32x4*)(p.norm_ffn_w + 4 * (lane + 64 * j));
    for (int r = gw; r < T; r += NGW) {
        f32x4 v[4]; float ss = 0.f;
#pragma unroll
        for (int j = 0; j < 4; ++j) { v[j] = *(const f32x4*)(H1 + (size_t)r * DM + 4 * (lane + 64 * j)); ss += v[j][0] * v[j][0] + v[j][1] * v[j][1] + v[j][2] * v[j][2] + v[j][3] * v[j][3]; }
        ss = wave_sum(ss);
        const float rs = rsqrtf(ss * (1.f / DM) + EPS);
#pragma unroll
        for (int j = 0; j < 4; ++j) { v[j] = v[j] * rs * wv[j]; u32x2 o; o.x = cvt_pk_bf16(v[j][0], v[j][1]); o.y = cvt_pk_bf16(v[j][2], v[j][3]);
            *(u32x2*)(U2 + (size_t)r * DM + 4 * (lane + 64 * j)) = o; }
    }
}

__device__ __forceinline__ void convert_tables(const Params& p, int tid) {
    const int gt = blockIdx.x * NTHREADS + tid, NGT = gridDim.x * NTHREADS;
    unsigned char* WD4 = p.ws + OFF_WD;
    unsigned char* WU8 = p.ws + OFF_WU;
    for (int c = gt; c < 2 * 16384 * 64; c += NGT) {
        const int which = c >> 20; const int cc = c & 1048575; const size_t e = (size_t)cc * 16;
        const float* src = (which ? p.w_up : p.w_down) + e;
        f32x4 a[4];
#pragma unroll
        for (int q = 0; q < 4; ++q) a[q] = *(const f32x4*)(src + 4 * q);
        {
            float mx = 0.f;
#pragma unroll
            for (int q = 0; q < 4; ++q) mx = fmaxf(fmaxf(fmaxf(fabsf(a[q][0]), fabsf(a[q][1])), fmaxf(fabsf(a[q][2]), fabsf(a[q][3]))), mx);
            const unsigned sb = cvt_pk_bf16(fmaxf(mx, 1e-30f) * (1.f / 6.f), 0.f) & 0xffffu;
            const float inv = __builtin_amdgcn_rcpf(__uint_as_float(sb << 16));
            u32x2 o;
#pragma unroll
            for (int d = 0; d < 2; ++d) { unsigned pk = 0u;
                pk = __builtin_amdgcn_cvt_scalef32_pk_fp4_f32(pk, a[2 * d][0] * inv, a[2 * d][1] * inv, 1.0f, 0);
                pk = __builtin_amdgcn_cvt_scalef32_pk_fp4_f32(pk, a[2 * d][2] * inv, a[2 * d][3] * inv, 1.0f, 1);
                pk = __builtin_amdgcn_cvt_scalef32_pk_fp4_f32(pk, a[2 * d + 1][0] * inv, a[2 * d + 1][1] * inv, 1.0f, 2);
                pk = __builtin_amdgcn_cvt_scalef32_pk_fp4_f32(pk, a[2 * d + 1][2] * inv, a[2 * d + 1][3] * inv, 1.0f, 3);
                o[d] = pk; }
            const int row = cc >> 6, ln = cc & 63;
            unsigned char* T4 = which ? WU8 : WD4;
            *(u32x2*)(T4 + (size_t)row * 640 + 8 * ln) = o;
            *(unsigned short*)(T4 + (size_t)row * 640 + 512 + 2 * ln) = (unsigned short)sb;
        }
    }
}

__device__ __forceinline__ int f2sort(float f) { const int b = __float_as_int(f); return b ^ ((b >> 31) & 0x7fffffff); }
__device__ __forceinline__ float sort2f(int s) { return __int_as_float(s ^ ((s >> 31) & 0x7fffffff)); }
#define CE_DESC(x, y) do { const int _hi = max(x, y), _lo = min(x, y); x = _hi; y = _lo; } while (0)
__device__ __forceinline__ void sort16_desc(int (&v)[16]) {
#pragma unroll
    for (int k = 2; k <= 16; k <<= 1)
#pragma unroll
        for (int j = k >> 1; j > 0; j >>= 1)
#pragma unroll
            for (int i = 0; i < 16; ++i) { const int l = i ^ j; if (l > i) { if ((i & k) == 0) CE_DESC(v[i], v[l]); else CE_DESC(v[l], v[i]); } }
}
__device__ __forceinline__ void merge_top16(int (&a)[16], const int (&b)[16]) {
#pragma unroll
    for (int i = 0; i < 16; ++i) a[i] = max(a[i], b[15 - i]);
#pragma unroll
    for (int j = 8; j > 0; j >>= 1)
#pragma unroll
        for (int i = 0; i < 16; ++i) if ((i & j) == 0) CE_DESC(a[i], a[i + j]);
}
#define CE_INSERT(arr, val) do { int _v = (val); _Pragma("unroll") for (int _j = 0; _j < 16; ++_j) { const int _hi = max(arr[_j], _v); _v = min(arr[_j], _v); arr[_j] = _hi; } } while (0)

__device__ __forceinline__ void topk_half(const bf16_t* Q, const bf16_t* KEYS, int t0, int h, int half, int lane, int (&a)[16]) {
#pragma unroll
    for (int j = 0; j < 16; ++j) a[j] = (int)0x80000000;
    bf16x8 qf[8];
    const bf16_t* qp = Q + (size_t)(t0 + (lane & 31)) * 2048 + h * 256 + half * 128 + 8 * (lane >> 5);
#pragma unroll
    for (int ks = 0; ks < 8; ++ks) qf[ks] = *(const bf16x8*)(qp + 16 * ks);
    const int lane_off = 4 * (lane >> 5);
#pragma unroll 1
    for (int kb = 0; kb < 4; ++kb) {
        const bf16_t* kp = KEYS + (size_t)((h * 2 + half) * 128 + 32 * kb + (lane & 31)) * 128 + 8 * (lane >> 5);
        f32x16 acc;
#pragma unroll
        for (int i = 0; i < 16; ++i) acc[i] = 0.f;
#pragma unroll
        for (int ks = 0; ks < 8; ++ks) { const bf16x8 kf = *(const bf16x8*)(kp + 16 * ks); acc = __builtin_amdgcn_mfma_f32_32x32x16_bf16(kf, qf[ks], acc, 0, 0, 0); }
int nv[16];
#pragma unroll
        for (int reg = 0; reg < 16; ++reg) {
            const int low = 127 - 32 * kb - (reg & 3) - 8 * (reg >> 2) - lane_off;
            nv[reg] = (f2sort(acc[reg]) & ~127) | low;
        }
        sort16_desc(nv); merge_top16(a, nv);
    }
    int pb[16];
#pragma unroll
    for (int j = 0; j < 16; ++j) pb[j] = xor32i(a[j], lane);
    merge_top16(a, pb);
}

__device__ __forceinline__ void phase9(const Params& p, LAS unsigned char* lds) {
    const int tid = opaque_tid(), lane = tid & 63, wave = tid >> 6;
    const bf16_t* Q = (const bf16_t*)p.out; const bf16_t* KEYS = (const bf16_t*)(p.ws + OFF_KEYS);
    unsigned short* IDX = (unsigned short*)(p.ws + OFF_IDX); float* GATE = (float*)(p.ws + OFF_GATE);
    LAS unsigned char* slot = lds + wave * 2048 + lane * 32;
    if (wave & 1) convert_tables(p, tid);
    pg8::StaticOrder S; S.init(T, 2048, gridDim.x, blockIdx.x);
    pg8::Unit u;
    for (int ui = 0; S.next(ui, u); ++ui) {
        const int h = u.pn, t0 = u.pm * 256 + 32 * wave;
        int a1[16], a2[16];
        topk_half(Q, KEYS, t0, h, 0, lane, a1);
        topk_half(Q, KEYS, t0, h, 1, lane, a2);
        float v1[16], v2[16];
#pragma unroll
        for (int i = 0; i < 16; ++i) { v1[i] = sort2f(a1[i] & ~127); v2[i] = sort2f(a2[i] & ~127); slot[i] = (unsigned char)(127 - (a1[i] & 127)); slot[16 + i] = (unsigned char)(127 - (a2[i] & 127)); }
#define CKEY(i, j) ((f2sort(v1[i] + v2[j]) & ~255) | (255 - ((i) * 16 + (j))))
        int cnd[16];
#pragma unroll
        for (int j = 0; j < 16; ++j) cnd[j] = CKEY(0, j);
#pragma unroll
        for (int i = 1; i < 5; ++i) { int d[16];
#pragma unroll
            for (int j = 0; j < 16; ++j) d[j] = (j < 16 / (i + 1)) ? CKEY(i, j) : (int)0x80000000;
            merge_top16(cnd, d); }
        { int d[16];
          d[0] = CKEY(5, 0); d[1] = CKEY(5, 1); d[2] = CKEY(6, 0); d[3] = CKEY(6, 1); d[4] = CKEY(7, 0); d[5] = CKEY(7, 1);
#pragma unroll
          for (int i = 8; i < 16; ++i) d[i - 2] = CKEY(i, 0);
          d[14] = (int)0x80000000; d[15] = (int)0x80000000;
          sort16_desc(d); merge_top16(cnd, d); }
#undef CKEY
        float ts[16], sum = 0.f; const float mx = sort2f(cnd[0] & ~255);
#pragma unroll
        for (int k = 0; k < 16; ++k) { ts[k] = __expf(sort2f(cnd[k] & ~255) - mx); sum += ts[k]; }
        const float inv = 1.f / sum;
        LDS_WAIT();
        unsigned ex[16];
#pragma unroll
        for (int k = 0; k < 16; ++k) { const int pos = 255 - (cnd[k] & 255); ex[k] = (unsigned)slot[pos >> 4] * 128u + (unsigned)slot[16 + (pos & 15)]; }
        if (lane < 32) {
            const size_t o = ((size_t)(t0 + lane) * 8 + h) * 16;
            u32x4 w0, w1;
            w0.x = ex[0] | (ex[1] << 16); w0.y = ex[2] | (ex[3] << 16); w0.z = ex[4] | (ex[5] << 16); w0.w = ex[6] | (ex[7] << 16);
            w1.x = ex[8] | (ex[9] << 16); w1.y = ex[10] | (ex[11] << 16); w1.z = ex[12] | (ex[13] << 16); w1.w = ex[14] | (ex[15] << 16);
            *(u32x4*)(IDX + o) = w0; *(u32x4*)(IDX + o + 8) = w1;
#pragma unroll
            for (int k4 = 0; k4 < 4; ++k4) *(f32x4*)(GATE + o + 4 * k4) = (f32x4){ts[4 * k4] * inv, ts[4 * k4 + 1] * inv, ts[4 * k4 + 2] * inv, ts[4 * k4 + 3] * inv};
        }
        LDS_WAIT();
    }
    if (!(wave & 1)) convert_tables(p, tid);
}

__device__ __forceinline__ float gelu_erf(float v) {
    const float av = fabsf(v), t = __builtin_amdgcn_rcpf(av * 0.2316418882f + 1.0f);
    float q = t * 0.5307027145f + (-0.7265760135f); q = q * t + 0.7107068705f; q = q * t + (-0.142248368f); q = q * t + 0.127414796f; q = q * t;
    const float e = __builtin_amdgcn_exp2f(v * v * (-0.72134752044f));
    const float m = v * (q * e);
    return v < 0.f ? m : v - m;
}
__device__ __forceinline__ void phase10(const Params& p) {
    const int tid = opaque_tid(), lane = tid & 63, wave = tid >> 6;
    const int gw = blockIdx.x * 8 + wave, NGW = gridDim.x * 8;
    const bf16_t* U2 = (const bf16_t*)(p.ws + OFF_Z); const unsigned char* WD4 = p.ws + OFF_WD; const unsigned char* WU8 = p.ws + OFF_WU;
    const unsigned short* IDX = (const unsigned short*)(p.ws + OFF_IDX); const float* GATE = (const float*)(p.ws + OFF_GATE);
    const float* H1 = (const float*)(p.ws + OFF_H1);
    const bool b0 = lane & 1, b1 = lane & 2, b2 = lane & 4;
    const int jmap = (b0 ? 4 : 0) + (b1 ? 2 : 0) + (b2 ? 1 : 0);
    const float* ROWSS = (const float*)(p.ws + OFF_ROWSS);
    f32x2 nw[8];
#pragma unroll
    for (int q = 0; q < 8; ++q) nw[q] = *(const f32x2*)(p.norm_ffn_w + 16 * lane + 2 * q);
    for (int t = gw; t < T; t += NGW) {
        const int i0 = IDX[(size_t)t * 128 + lane], i1 = IDX[(size_t)t * 128 + 64 + lane];
        const float g0 = GATE[(size_t)t * 128 + lane] , g1 = GATE[(size_t)t * 128 + 64 + lane];
        f32x2 xv[8];
        { const u32x4 xa = *(const u32x4*)(U2 + (size_t)t * DM + 16 * lane), xb = *(const u32x4*)(U2 + (size_t)t * DM + 16 * lane + 8);
          const f32x4* rp = (const f32x4*)(ROWSS + (size_t)t * 16); const f32x4 s0 = rp[0], s1 = rp[1], s2 = rp[2], s3 = rp[3];
          const float tot = ((s0[0] + s0[1]) + (s0[2] + s0[3])) + ((s1[0] + s1[1]) + (s1[2] + s1[3])) + ((s2[0] + s2[1]) + (s2[2] + s2[3])) + ((s3[0] + s3[1]) + (s3[2] + s3[3]));
          const float rsc = rsqrtf(tot * (1.f / 1024.f) + EPS);
#pragma unroll
          for (int q = 0; q < 4; ++q) { xv[q] = (f32x2){bf_lo(xa[q]), bf_hi(xa[q])} * rsc * nw[q]; xv[4 + q] = (f32x2){bf_lo(xb[q]), bf_hi(xb[q])} * rsc * nw[4 + q]; } }
        f32x2 acc[8];
#pragma unroll
        for (int i = 0; i < 8; ++i) acc[i] = (f32x2){0.f, 0.f};
#pragma unroll 1
        for (int kk = 0; kk < 128; kk += 8) {
            u32x2 dw[8]; unsigned short dsc[8]; u32x2 uw[8]; unsigned short usc[8];
            const int isel = kk < 64 ? i0 : i1;
#pragma unroll
            for (int j = 0; j < 8; ++j) {
                const int e = __builtin_amdgcn_readlane(isel, (kk + j) & 63);
                const unsigned char* dr = WD4 + (size_t)e * 640;
                dw[j] = *(const u32x2*)(dr + 8 * lane); dsc[j] = *(const unsigned short*)(dr + 512 + 2 * lane); const unsigned char* ur = WU8 + (size_t)e * 640; uw[j] = *(const u32x2*)(ur + 8 * lane); usc[j] = *(const unsigned short*)(ur + 512 + 2 * lane);
            }
            float pd[8];
#pragma unroll
            for (int j = 0; j < 8; ++j) { f32x2 sacc = {0.f, 0.f};
#pragma unroll
                for (int d = 0; d < 2; ++d) {
                    sacc += __builtin_amdgcn_cvt_scalef32_pk_f32_fp4(dw[j][d], 1.0f, 0) * xv[4 * d]; sacc += __builtin_amdgcn_cvt_scalef32_pk_f32_fp4(dw[j][d], 1.0f, 1) * xv[4 * d + 1];
                    sacc += __builtin_amdgcn_cvt_scalef32_pk_f32_fp4(dw[j][d], 1.0f, 2) * xv[4 * d + 2]; sacc += __builtin_amdgcn_cvt_scalef32_pk_f32_fp4(dw[j][d], 1.0f, 3) * xv[4 * d + 3]; }
                pd[j] = (sacc.x + sacc.y) * __uint_as_float((unsigned)dsc[j] << 16); }
            float r4[4], r2[2], r1;
#pragma unroll
            for (int i = 0; i < 4; ++i) { const float send = b0 ? pd[i] : pd[i + 4], keep = b0 ? pd[i + 4] : pd[i];
                r4[i] = keep + __int_as_float(__builtin_amdgcn_update_dpp(0, __float_as_int(send), 0xB1, 0xf, 0xf, false)); }
#pragma unroll
            for (int i = 0; i < 2; ++i) { const float send = b1 ? r4[i] : r4[i + 2], keep = b1 ? r4[i + 2] : r4[i];
                r2[i] = keep + __int_as_float(__builtin_amdgcn_update_dpp(0, __float_as_int(send), 0x4E, 0xf, 0xf, false)); }
            { const float send = b2 ? r2[0] : r2[1], keep = b2 ? r2[1] : r2[0]; r1 = keep + swz_xor(send, 0x101F); }
            r1 += swz_xor(r1, 0x201F); r1 += swz_xor(r1, 0x401F); r1 += __shfl_xor(r1, 32);
            const int gsel = __float_as_int(kk < 64 ? g0 : g1);
            const float gel = gelu_erf(r1) * __int_as_float(__builtin_amdgcn_ds_bpermute(4 * ((kk + jmap) & 63), gsel));
#pragma unroll
            for (int j = 0; j < 8; ++j) {
                const int Lj = (j >> 2) + 2 * ((j >> 1) & 1) + 4 * (j & 1);
                const float a = __int_as_float(__builtin_amdgcn_readlane(__float_as_int(gel), Lj)) * __uint_as_float((unsigned)usc[j] << 16);
#pragma unroll
                for (int d = 0; d < 2; ++d) {
                    acc[4 * d + 0] += __builtin_amdgcn_cvt_scalef32_pk_f32_fp4(uw[j][d], 1.0f, 0) * a; acc[4 * d + 1] += __builtin_amdgcn_cvt_scalef32_pk_f32_fp4(uw[j][d], 1.0f, 1) * a;
                    acc[4 * d + 2] += __builtin_amdgcn_cvt_scalef32_pk_f32_fp4(uw[j][d], 1.0f, 2) * a; acc[4 * d + 3] += __builtin_amdgcn_cvt_scalef32_pk_f32_fp4(uw[j][d], 1.0f, 3) * a; }
            }
        }
        const float* hp = H1 + (size_t)t * DM + 16 * lane;
        f32x4 hv[4]; float ss = 0.f;
#pragma unroll
        for (int q = 0; q < 4; ++q) { hv[q] = *(const f32x4*)(hp + 4 * q); hv[q][0] += acc[2 * q][0]; hv[q][1] += acc[2 * q][1]; hv[q][2] += acc[2 * q + 1][0]; hv[q][3] += acc[2 * q + 1][1];
            ss += hv[q][0] * hv[q][0] + hv[q][1] * hv[q][1] + hv[q][2] * hv[q][2] + hv[q][3] * hv[q][3]; }
        ss = wave_sum(ss);
        const float rs = rsqrtf(ss * (1.f / DM) + EPS);
        float* op = p.out + (size_t)t * DM + 16 * lane;
#pragma unroll
        for (int q = 0; q < 4; ++q) { const f32x4 w = *(const f32x4*)(p.norm_final_w + 16 * lane + 4 * q); *(f32x4*)(op + 4 * q) = hv[q] * rs * w; }
    }
}

__global__ void __launch_bounds__(NTHREADS, 2) hymba_fwd(Params p) {
    extern __shared__ __attribute__((aligned(16))) unsigned char smem[];
    LAS unsigned char* lds = (LAS unsigned char*)smem;
    cg::grid_group grid = cg::this_grid();
    const int lo = p.ph_lo, hi = p.ph_hi;
#ifndef PH_MASK
#define PH_MASK 0x7ff
#endif
#define IN(k) (((PH_MASK >> (k)) & 1) && lo <= (k) && (k) < hi)
#define SEAM(k) do { if (IN(k) && IN((k) + 1)) { SEAM_BODY(); } } while (0)
#define SEAM_BODY() do { { \
        asm volatile("s_waitcnt vmcnt(0) lgkmcnt(0)" ::: "memory"); __syncthreads(); \
        ++bar_gen; \
        if (threadIdx.x == 0) { \
            if (bar_gen == 1u) {         \
                unsigned nx_, mine_, sum_; \
                do { nx_ = 0u; mine_ = 0u; sum_ = 0u; \
                    _Pragma("unroll") for (unsigned x_ = 0; x_ < 8; ++x_) { const unsigned c_ = __hip_atomic_load(bar + 640 + 16 * x_, __ATOMIC_RELAXED, __HIP_MEMORY_SCOPE_AGENT); sum_ += c_; nx_ += c_ > 0u ? 1u : 0u; mine_ = (x_ == my_xcc) ? c_ : mine_; } \
                    if (sum_ != gridDim.x) __builtin_amdgcn_s_sleep(1); } while (sum_ != gridDim.x); \
                xcc_n = mine_; xcc_pop = nx_; \
            } \
            { \
                const unsigned k_ = bar_gen; \
                const unsigned old_ = __hip_atomic_fetch_add(bar + 768 + 16 * my_xcc, 1u, __ATOMIC_RELAXED, __HIP_MEMORY_SCOPE_AGENT); \
                if (old_ + 1u == k_ * xcc_n) { __builtin_amdgcn_fence(__ATOMIC_RELEASE, "agent"); __hip_atomic_fetch_add(bar + 32, 1u, __ATOMIC_RELAXED, __HIP_MEMORY_SCOPE_AGENT); } \
                const unsigned target = k_ * xcc_pop; \
                while (__hip_atomic_load(bar + 32, __ATOMIC_RELAXED, __HIP_MEMORY_SCOPE_AGENT) < target) __builtin_amdgcn_s_sleep(1); \
            } \
            __builtin_amdgcn_fence(__ATOMIC_ACQUIRE, "agent"); \
            asm volatile("s_waitcnt vmcnt(0)" ::: "memory"); \
        } \
        __syncthreads(); } } while (0)
    unsigned* bar = (unsigned*)(p.ws + OFF_BAR); unsigned bar_gen = 0;
    const unsigned bar_ngrp = (gridDim.x % 8 == 0) ? 8u : 1u, bar_grp = blockIdx.x % bar_ngrp, bar_gsz = gridDim.x / bar_ngrp;
    unsigned my_xcc = 0u, xcc_n = 1u, xcc_pop = 1u;
    if (threadIdx.x == 0) { my_xcc = (unsigned)__builtin_amdgcn_s_getreg((3 << 11) | 20) & 7u;
        __hip_atomic_fetch_add(bar + 640 + 16 * my_xcc, 1u, __ATOMIC_RELAXED, __HIP_MEMORY_SCOPE_AGENT); }
    if (lo < 0) grid.sync();
    if (IN(0)) phase0(p, lds);
    SEAM(0);
    if (IN(1)) {
        pg8::Gemm g{(const bf16_t*)(p.ws + OFF_U) + (size_t)NMETA * DM, (const bf16_t*)(p.ws + OFF_U) + (size_t)NMETA * DM, (const bf16_t*)(p.ws + OFF_WTIN), T, NPROJ, DM, DM, 1 << 20};
        pg8::StaticOrder S; S.init(T, NPROJ, gridDim.x, blockIdx.x);
        pg8::EpiProj E{(bf16_t*)(p.ws + OFF_Z), DM, (bf16_t*)(p.ws + OFF_XC), 4096, NMETA, 1024, nullptr};
        pg8::gemm_phase<pg8::EpiProj>(lds, g, S, E);
        phase1_meta(p);
    }
    SEAM(1);
    if (IN(2)) phase2(p, lds);
    SEAM(2);
    if (IN(3)) phase3(p, lds);
    SEAM(3);
    if (IN(4)) phase4(p);
    SEAM(4);
    if (IN(5)) phase5(p, lds);
    SEAM(5);
    if (IN(6)) {
        pg8::Gemm g{(const bf16_t*)(p.ws + OFF_YSSD), (const bf16_t*)(p.ws + OFF_U), (const bf16_t*)(p.ws + OFF_WTOUT), T, DM, 2048, DM, 16};
        pg8::StaticOrder S; S.init(T, DM, gridDim.x, blockIdx.x);
        pg8::EpiRes E{(float*)(p.ws + OFF_H1), p.x, DM, (bf16_t*)(p.ws + OFF_Z), (float*)(p.ws + OFF_ROWSS)};
        pg8::gemm_phase<pg8::EpiRes>(lds, g, S, E);
    }
    if (IN(6) && IN(8)) { SEAM_BODY(); }
    if (IN(8)) {
        pg8::Gemm g{(const bf16_t*)(p.ws + OFF_Z), (const bf16_t*)(p.ws + OFF_Z), (const bf16_t*)(p.ws + OFF_WTQ), T, 2048, DM, DM, 1 << 20};
        pg8::StaticOrder S; S.init(T, 2048, gridDim.x, blockIdx.x);
        pg8::EpiProj E{(bf16_t*)p.out, 2048, (bf16_t*)p.out, 2048, 0, 1 << 20, (const float*)(p.ws + OFF_ROWSS)};
        pg8::gemm_phase<pg8::EpiProj>(lds, g, S, E);
        phase9(p, lds);
    }
    if (IN(8) && IN(10)) { SEAM_BODY(); }
    if (IN(10)) phase10(p);
#undef IN
#undef SEAM
}

#ifndef MK_MULTI
#define MK_MULTI 0
#endif
extern "C" void kernel_launch(void* const* d_in, const int* in_sizes, int n_in, void* d_out, int out_size, void* d_ws, size_t ws_size, hipStream_t stream) {
    static int grid = 0;
    if (grid == 0) {
        if (n_in != 22 || out_size != T * DM || ws_size < WS_END) { fprintf(stderr, "kernel_launch: unexpected shapes (n_in %d out %d ws %zu need %zu)\n", n_in, out_size, ws_size, (size_t)WS_END); grid = -1; return; }
        int dev = 0, cus = 0, per_cu = 0;
        hipGetDevice(&dev); hipDeviceGetAttribute(&cus, hipDeviceAttributeMultiprocessorCount, dev);
        if (hipFuncSetAttribute((const void*)hymba_fwd, hipFuncAttributeMaxDynamicSharedMemorySize, LDS_BYTES) != hipSuccess) { fprintf(stderr, "kernel_launch: hipFuncSetAttribute failed\n"); grid = -1; return; }
        if (hipOccupancyMaxActiveBlocksPerMultiprocessor(&per_cu, (const void*)hymba_fwd, NTHREADS, LDS_BYTES) != hipSuccess || per_cu < 1) { fprintf(stderr, "kernel_launch: occupancy query gave %d\n", per_cu); per_cu = 1; (void)hipGetLastError(); }
        grid = cus * per_cu;
        fprintf(stderr, "kernel_launch: grid %d (cus %d x %d)\n", grid, cus, per_cu);
    }
    if (grid < 0) return;
    Params p{};
    p.x = (const float*)d_in[0]; p.meta = (const float*)d_in[1]; p.norm_mix_w = (const float*)d_in[2]; p.w_in = (const float*)d_in[3];
    p.ssd_conv_w = (const float*)d_in[4]; p.ssd_conv_b = (const float*)d_in[5]; p.dt_bias = (const float*)d_in[6]; p.A_log = (const float*)d_in[7];
    p.Dskip = (const float*)d_in[8]; p.ssd_norm_w = (const float*)d_in[9]; p.conf_w = (const float*)d_in[10]; p.conf_b = (const float*)d_in[11];
    p.ln_g = (const float*)d_in[12]; p.ln_b = (const float*)d_in[13]; p.w_out = (const float*)d_in[14]; p.norm_ffn_w = (const float*)d_in[15];
    p.w_query = (const float*)d_in[16]; p.keys1 = (const float*)d_in[17]; p.keys2 = (const float*)d_in[18]; p.w_down = (const float*)d_in[19];
    p.w_up = (const float*)d_in[20]; p.norm_final_w = (const float*)d_in[21];
    p.out = (float*)d_out; p.ws = (unsigned char*)d_ws;
#if MK_MULTI
    for (int ph = 0; ph < 11; ++ph) { p.ph_lo = ph; p.ph_hi = ph + 1; hipLaunchKernelGGL(hymba_fwd, dim3(grid), dim3(NTHREADS), LDS_BYTES, stream, p); }
#else
    p.ph_lo = 0; p.ph_hi = 11;
    if (hipMemsetAsync((char*)d_ws + OFF_BAR, 0, 4096, stream) != hipSuccess) fprintf(stderr, "kernel_launch: memset failed\n");
    void* args[] = {&p};
    hipError_t e = hipLaunchCooperativeKernel((const void*)hymba_fwd, dim3(grid), dim3(NTHREADS), args, LDS_BYTES, stream);
    if (e != hipSuccess) fprintf(stderr, "kernel_launch: cooperative launch failed: %s (grid %d)\n", hipGetErrorString(e), grid);
#endif
}
```

```cpp
#include <hip/hip_runtime.h>
#include <hip/hip_cooperative_groups.h>
#include <cstdio>
#include <cstdint>
namespace cg = cooperative_groups;

#define LAS __attribute__((address_space(3)))
typedef unsigned short bf16_t;
typedef short bf16x8 __attribute__((ext_vector_type(8)));
typedef float f32x4 __attribute__((ext_vector_type(4)));
typedef float f32x2 __attribute__((ext_vector_type(2)));
typedef float f32x16 __attribute__((ext_vector_type(16)));
typedef unsigned u32x4 __attribute__((ext_vector_type(4)));
typedef unsigned u32x2 __attribute__((ext_vector_type(2)));
typedef __bf16 bf2_t __attribute__((ext_vector_type(2)));

constexpr int NB = 8, SEQ = 2048, NMETA = 16, DM = 1024;
constexpr int T = NB * SEQ;
constexpr int R = T + NMETA;
constexpr int DIN = 5136;
constexpr int NPROJ = 5120;
constexpr int NTHREADS = 512;
constexpr float EPS = 1e-5f;
constexpr int LDS_BYTES = 135168;
constexpr float WD_SCALE = 64.f, WU_SCALE = 8.f;

constexpr size_t OFF_XC = 0;
constexpr size_t OFF_ST = 0;
constexpr size_t OFF_WD = 67108864;
constexpr size_t OFF_WU = OFF_WD + 16777216;
constexpr size_t OFF_H1 = 0;
constexpr size_t OFF_Z = 134349056;
constexpr size_t OFF_U = OFF_Z + 33554432;
constexpr size_t OFF_IDX = OFF_U;
constexpr size_t OFF_GATE = OFF_U + 4194304;
constexpr size_t OFF_WTIN = OFF_U + 33587200;
constexpr size_t OFF_WTOUT = OFF_WTIN + 10485760 + 65536;
constexpr size_t OFF_WTQ = OFF_WTOUT + 4194304;
constexpr size_t OFF_KEYS = OFF_WTQ + 4194304;
constexpr size_t OFF_DTRAW = OFF_KEYS + 524288;
constexpr size_t OFF_XBCM = OFF_DTRAW + 1049600;
constexpr size_t OFF_CDEC = OFF_XBCM + 65536;
constexpr size_t OFF_YSSD = OFF_CDEC + 8192;
constexpr size_t OFF_BAR = OFF_YSSD + 33554432;
constexpr size_t OFF_ROWSS = OFF_BAR + 4096;
constexpr size_t OFF_ACS = OFF_ROWSS + 1048576;
constexpr size_t WS_END = OFF_ACS + 512 * 4096;

struct Params {
    const float* x; const float* meta; const float* norm_mix_w; const float* w_in; const float* ssd_conv_w; const float* ssd_conv_b;
    const float* dt_bias; const float* A_log; const float* Dskip; const float* ssd_norm_w; const float* conf_w; const float* conf_b;
    const float* ln_g; const float* ln_b; const float* w_out; const float* norm_ffn_w; const float* w_query; const float* keys1; const float* keys2;
    const float* w_down; const float* w_up; const float* norm_final_w;
    float* out; unsigned char* ws; int ph_lo, ph_hi;
};

__device__ __forceinline__ unsigned cvt_pk_bf16(float lo, float hi) { const f32x2 v = {lo, hi}; return __builtin_bit_cast(unsigned, __builtin_convertvector(v, bf2_t)); }
__device__ __forceinline__ float bf_lo(unsigned u) { return __uint_as_float(u << 16); }
__device__ __forceinline__ float bf_hi(unsigned u) { return __uint_as_float(u & 0xffff0000u); }
#define DPP_ADD(v, ctrl) v += __int_as_float(__builtin_amdgcn_update_dpp(0, __float_as_int(v), ctrl, 0xf, 0xf, false))
__device__ __forceinline__ float wave_sum(float v) {
    DPP_ADD(v, 0xB1); DPP_ADD(v, 0x4E); DPP_ADD(v, 0x141); DPP_ADD(v, 0x140);
    v += __int_as_float(__builtin_amdgcn_ds_swizzle(__float_as_int(v), 0x401F));
    return __int_as_float(__builtin_amdgcn_readlane(__float_as_int(v), 0)) + __int_as_float(__builtin_amdgcn_readlane(__float_as_int(v), 32));
}
__device__ __forceinline__ int xor32i(int v, int lane) {
    (void)lane; return __shfl_xor(v, 32);
}
__device__ __forceinline__ float xor16f(float v) { return __int_as_float(__builtin_amdgcn_ds_swizzle(__float_as_int(v), 0x401F)); }
__device__ __forceinline__ int opaque_tid() { int t; asm volatile("v_mov_b32 %0, %1" : "=v"(t) : "v"((int)threadIdx.x)); return t; }
__device__ __forceinline__ float sigmoidf_(float v) { return __builtin_amdgcn_rcpf(1.f + __builtin_amdgcn_exp2f(v * -1.44269504f)); }
__device__ __forceinline__ float siluf_(float v) { return v * __builtin_amdgcn_rcpf(1.f + __builtin_amdgcn_exp2f(v * -1.44269504f)); }
__device__ __forceinline__ float softplusf_(float v) {
    const float e = __builtin_amdgcn_exp2f(fabsf(v) * -1.44269504f);
    const float l = e < 1e-3f ? e * (1.f - 0.5f * e) : __builtin_amdgcn_logf(1.f + e) * 0.69314718f;
    return fmaxf(v, 0.f) + l;
}
#define swz_xor(v, pat) __int_as_float(__builtin_amdgcn_ds_swizzle(__float_as_int(v), pat))
#define LDS_WAIT() asm volatile("s_waitcnt lgkmcnt(0)" ::: "memory")

namespace pg8 {
constexpr int BM = 256, BK = 64, HALF = 128, HTB = HALF * BK * 2, STAGE_BYTES = 8 * HTB, NXCD = 8, WGM = 8;
__device__ __forceinline__ int lds_byte(int r, int c) { const int st = (r >> 4) * 2 + (c >> 5), rr = r & 15, cc = c & 31, ob = rr * 64 + cc * 2; return st * 1024 + (ob ^ (((ob >> 9) & 1) << 5)); }
__device__ __forceinline__ void stage_rc(int b, int& Rr, int& C) { const int st = b / 1024, sb = b % 1024, swz = sb ^ (((sb >> 9) & 1) << 5); Rr = (st >> 1) * 16 + swz / 64; C = (st & 1) * 32 + (swz % 64) / 2; }
__device__ __forceinline__ int perm32(int rho) { const int n = rho >> 4, i = rho & 15; return 8 * (i >> 2) + 4 * n + (i & 3); }
struct Unit { int pm, pn; };
struct Gemm { const bf16_t* A0; const bf16_t* A1; const bf16_t* Bt; int M, N, K, lda, tsplit; };
struct StaticOrder {
    int nM, nN, nwg, G, c;
    __device__ void init(int M, int N, int G_, int c_) { nM = M / BM; nN = N / BM; nwg = nM * nN; G = G_; c = c_; }
    __device__ bool next(int i, Unit& u) const {
        const long L = (long)i * G + c; if (L >= nwg) return false;
        int wgid = (int)L; { const int q = nwg / NXCD, r = nwg % NXCD, xcd = wgid % NXCD, off = wgid / NXCD; wgid = (xcd < r ? xcd * (q + 1) : r * (q + 1) + (xcd - r) * q) + off; }
        const int nig = WGM * nN, gid = wgid / nig, fm = gid * WGM, gsz = (nM - fm) < WGM ? (nM - fm) : WGM;
        u.pm = fm + ((wgid % nig) % gsz); u.pn = (wgid % nig) / gsz; return true;
    }
};

template <class Epi>
__device__ __forceinline__ void gemm_phase(LAS unsigned char* lds, const Gemm g, const StaticOrder& S, const Epi& E) {
    const int tid = opaque_tid(), wid = __builtin_amdgcn_readfirstlane(tid >> 6), lane = tid & 63, wr = wid >> 2, wc = wid & 3, fr = lane & 15, fq = lane >> 4;
    const int K = g.K, nt = K / BK, lda = g.lda, tsplit = g.tsplit;
    unsigned voffA[2], voffB[2];
#pragma unroll
    for (int i = 0; i < 2; ++i) { int Rr, C; stage_rc(tid * 16 + i * 8192, Rr, C); const int Rb = Epi::PERM ? ((Rr & ~31) + perm32(Rr & 31)) : Rr;
        voffA[i] = (unsigned)(Rr * lda + C) * 2u; voffB[i] = (unsigned)(Rb * K + C) * 2u; }
    const size_t kstep = (size_t)(BK * 2);
    const size_t hstepA = (size_t)HALF * lda * 2, tstepA = 2 * hstepA;
    const size_t hstepB = (size_t)HALF * K * 2, tstepB = 2 * hstepB;
    const unsigned ldsw = (unsigned)wid * 1024u;
    const int aoff = lds_byte(wr * 64 + fr, fq * 8), boff = lds_byte(wc * 32 + fr, fq * 8);
#define PG8_SA(b, h) (((b) * 2 + (h)) * HTB)
#define PG8_SB(b, h) ((4 + (b) * 2 + (h)) * HTB)
#define PG8_STAGE(bufoff, gbase, voff) do { _Pragma("unroll") for (int _i = 0; _i < 2; ++_i) \
        __builtin_amdgcn_global_load_lds((const unsigned*)((const char*)(gbase) + (voff)[_i]), (LAS unsigned*)(lds + (bufoff) + ldsw + _i * 8192), 16, 0, 0); } while (0)
#define PG8_LDA(dst, b, h) do { _Pragma("unroll") for (int m = 0; m < 4; ++m) _Pragma("unroll") for (int k = 0; k < 2; ++k) dst[m][k] = *(const LAS bf16x8*)(lds + PG8_SA(b, h) + aoff + m * 2048 + k * 1024); } while (0)
#define PG8_LDB(dst, b, h) do { _Pragma("unroll") for (int n = 0; n < 2; ++n) _Pragma("unroll") for (int k = 0; k < 2; ++k) dst[n][k] = *(const LAS bf16x8*)(lds + PG8_SB(b, h) + boff + n * 2048 + k * 1024); } while (0)
#define PG8_MMA(ai, bj, At, Bt) do { __builtin_amdgcn_s_setprio(1); _Pragma("unroll") for (int m = 0; m < 4; ++m) _Pragma("unroll") for (int n = 0; n < 2; ++n) _Pragma("unroll") for (int k = 0; k < 2; ++k) \
        acc[ai][bj][m][n] = __builtin_amdgcn_mfma_f32_16x16x32_bf16(Bt[n][k], At[m][k], acc[ai][bj][m][n], 0, 0, 0); __builtin_amdgcn_s_setprio(0); } while (0)
#define PG8_WAIT_V(n) asm volatile("s_waitcnt vmcnt(" #n ")" ::: "memory")
#define PG8_WAIT_L(n) asm volatile("s_waitcnt lgkmcnt(" #n ")" ::: "memory")
#define PG8_BAR __builtin_amdgcn_s_barrier()
#define PG8_SCHED __builtin_amdgcn_sched_barrier(0)
#define PG8_KPTR(c0, c1, t) ((t) < tsplit ? (c0) + (size_t)(t) * kstep : (c1) + (size_t)((t) - tsplit) * kstep)
    Unit cur, nxt; int ui = 0;
    if (!S.next(0, cur)) return;
    f32x4 acc[2][2][4][2];
#pragma unroll
    for (int a = 0; a < 2; ++a)
#pragma unroll
        for (int b = 0; b < 2; ++b)
#pragma unroll
            for (int m = 0; m < 4; ++m)
#pragma unroll
                for (int n = 0; n < 2; ++n) acc[a][b][m][n] = (f32x4){0.f, 0.f, 0.f, 0.f};
    bf16x8 At[4][2], B0[2][2], B1[2][2];
    const char* cA = (const char*)g.A0 + (size_t)cur.pm * tstepA; const char* cA1 = (const char*)g.A1 + (size_t)cur.pm * tstepA;
    const char* cB = (const char*)g.Bt + (size_t)cur.pn * tstepB;
    PG8_STAGE(PG8_SB(0, 0), cB, voffB); PG8_STAGE(PG8_SA(0, 0), cA, voffA); PG8_STAGE(PG8_SB(0, 1), cB + hstepB, voffB); PG8_STAGE(PG8_SA(0, 1), cA + hstepA, voffA);
    if (wr == 1) PG8_BAR;
    PG8_WAIT_V(4); PG8_BAR;
    PG8_STAGE(PG8_SB(1, 0), cB + kstep, voffB); PG8_STAGE(PG8_SA(1, 0), cA + kstep, voffA); PG8_STAGE(PG8_SB(1, 1), cB + hstepB + kstep, voffB);
    PG8_WAIT_V(6); PG8_BAR;
    for (;;) {
        const bool has_next = S.next(ui + 1, nxt);
        const char* nA = has_next ? (const char*)g.A0 + (size_t)nxt.pm * tstepA : cA; const char* nA1 = has_next ? (const char*)g.A1 + (size_t)nxt.pm * tstepA : cA1;
        const char* nB = has_next ? (const char*)g.Bt + (size_t)nxt.pn * tstepB : cB;
        for (int t = 0; t < nt; t += 2) {
            const bool last = (t == nt - 2);
            const char* a1 = PG8_KPTR(cA, cA1, t + 1);
            const char* a2 = last ? nA : PG8_KPTR(cA, cA1, t + 2); const char* b2 = last ? nB : cB + (size_t)(t + 2) * kstep;
            const char* a3 = a2 + kstep; const char* b3 = b2 + kstep;
            PG8_LDB(B0, 0, 0); PG8_SCHED; PG8_LDA(At, 0, 0); PG8_STAGE(PG8_SA(1, 1), a1 + hstepA, voffA);
            PG8_WAIT_L(8); PG8_BAR; PG8_WAIT_L(0); PG8_MMA(0, 0, At, B0); PG8_BAR; PG8_SCHED;
            PG8_LDB(B1, 0, 1); PG8_STAGE(PG8_SB(0, 0), b2, voffB);
            PG8_BAR; PG8_WAIT_L(0); PG8_MMA(0, 1, At, B1); PG8_BAR;
            PG8_LDA(At, 0, 1); PG8_STAGE(PG8_SA(0, 0), a2, voffA);
            PG8_BAR; PG8_WAIT_L(0); PG8_MMA(1, 0, At, B0); PG8_BAR; PG8_SCHED;
            PG8_STAGE(PG8_SB(0, 1), b2 + hstepB, voffB);
            PG8_WAIT_V(6); PG8_BAR; PG8_MMA(1, 1, At, B1); PG8_BAR;
            PG8_LDB(B0, 1, 0); PG8_SCHED; PG8_LDA(At, 1, 0); PG8_STAGE(PG8_SA(0, 1), a2 + hstepA, voffA);
            PG8_WAIT_L(8); PG8_BAR; PG8_WAIT_L(0); PG8_MMA(0, 0, At, B0); PG8_BAR; PG8_SCHED;
            PG8_LDB(B1, 1, 1); PG8_STAGE(PG8_SB(1, 0), b3, voffB);
            PG8_BAR; PG8_WAIT_L(0); PG8_MMA(0, 1, At, B1); PG8_BAR;
            PG8_LDA(At, 1, 1); PG8_STAGE(PG8_SA(1, 0), a3, voffA);
            PG8_BAR; PG8_WAIT_L(0); PG8_MMA(1, 0, At, B0); PG8_BAR; PG8_SCHED;
            PG8_STAGE(PG8_SB(1, 1), b3 + hstepB, voffB);
            PG8_WAIT_V(6); PG8_BAR; PG8_MMA(1, 1, At, B1); PG8_BAR;
        }
        E(acc, cur, wr, wc, fr, fq);
        if (!has_next) break;
#pragma unroll
        for (int a = 0; a < 2; ++a)
#pragma unroll
            for (int b = 0; b < 2; ++b)
#pragma unroll
                for (int m = 0; m < 4; ++m)
#pragma unroll
                    for (int n = 0; n < 2; ++n) acc[a][b][m][n] = (f32x4){0.f, 0.f, 0.f, 0.f};
        cur = nxt; cA = nA; cA1 = nA1; cB = nB; ++ui;
    }
    PG8_WAIT_V(0);
    if (wr == 0) PG8_BAR;
    PG8_BAR;
#undef PG8_SA
#undef PG8_SB
#undef PG8_STAGE
#undef PG8_LDA
#undef PG8_LDB
#undef PG8_MMA
#undef PG8_WAIT_V
#undef PG8_WAIT_L
#undef PG8_BAR
#undef PG8_SCHED
#undef PG8_KPTR
}

struct EpiProj {
    static constexpr bool PERM = true;
    bf16_t* O0; int ld0; bf16_t* O1; int ld1; int rowoff1; int csplit; const float* rowss;
    __device__ __forceinline__ void operator()(const f32x4 (&acc)[2][2][4][2], const Unit& u, int wr, int wc, int fr, int fq) const {
        int row0 = u.pm * BM + wr * 64 + fr; int colt = u.pn * BM; bf16_t* base = O0; int ldc = ld0;
        if (colt >= csplit) { base = O1; ldc = ld1; colt -= csplit; row0 += rowoff1; }
        const int col0 = colt + wc * 32 + 8 * fq;
#pragma unroll
        for (int ai = 0; ai < 2; ++ai)
#pragma unroll
            for (int m = 0; m < 4; ++m) { bf16_t* rowp = base + (size_t)(row0 + ai * HALF + m * 16) * ldc + col0;
                float rsc = 1.f;
                if (rowss) { const f32x4* rp = (const f32x4*)(rowss + (size_t)(row0 + ai * HALF + m * 16) * 16); const f32x4 s0 = rp[0], s1 = rp[1], s2 = rp[2], s3 = rp[3];
                    const float tot = ((s0[0] + s0[1]) + (s0[2] + s0[3])) + ((s1[0] + s1[1]) + (s1[2] + s1[3])) + ((s2[0] + s2[1]) + (s2[2] + s2[3])) + ((s3[0] + s3[1]) + (s3[2] + s3[3]));
                    rsc = rsqrtf(tot * (1.f / 1024.f) + EPS); }
#pragma unroll
                for (int bj = 0; bj < 2; ++bj) { const f32x4 v0 = acc[ai][bj][m][0] * rsc, v1 = acc[ai][bj][m][1] * rsc;
                    u32x4 w; w.x = cvt_pk_bf16(v0[0], v0[1]); w.y = cvt_pk_bf16(v0[2], v0[3]); w.z = cvt_pk_bf16(v1[0], v1[1]); w.w = cvt_pk_bf16(v1[2], v1[3]);
                    *(u32x4*)(rowp + bj * HALF) = w; } }
    }
};
struct EpiRes {
    static constexpr bool PERM = false;
    float* C; const float* res; int ldc; bf16_t* HB; float* rowss;
    __device__ __forceinline__ void operator()(const f32x4 (&acc)[2][2][4][2], const Unit& u, int wr, int wc, int fr, int fq) const {
        const int row0 = u.pm * BM + wr * 64 + fr, col0 = u.pn * BM + wc * 32 + 4 * fq;
#pragma unroll
        for (int ai = 0; ai < 2; ++ai)
#pragma unroll
            for (int m = 0; m < 4; ++m) { const int row = row0 + ai * HALF + m * 16; const size_t ro = (size_t)row * ldc + col0; float ssq = 0.f;
#pragma unroll
                for (int bj = 0; bj < 2; ++bj)
#pragma unroll
                    for (int n = 0; n < 2; ++n) { const f32x4 rv = *(const f32x4*)(res + ro + bj * HALF + n * 16); const f32x4 v = acc[ai][bj][m][n] + rv;
                        *(f32x4*)(C + ro + bj * HALF + n * 16) = v;
                        u32x2 o; o.x = cvt_pk_bf16(v[0], v[1]); o.y = cvt_pk_bf16(v[2], v[3]); *(u32x2*)(HB + ro + bj * HALF + n * 16) = o;
                        ssq += v[0] * v[0] + v[1] * v[1] + v[2] * v[2] + v[3] * v[3]; }
                ssq += xor16f(ssq); ssq += __shfl_xor(ssq, 32);
                if (fq == 0) rowss[(size_t)row * 16 + 4 * u.pn + wc] = ssq; }
    }
};
}

__device__ __forceinline__ void transpose_item(const float* W, int ldw, int K, bf16_t* WT, int nblk, int item, int lane, LAS float* scr, bool is_win, const float* kscale = nullptr) {
    const int kb = item / nblk, nb = item % nblk, k0 = 64 * kb, n0 = 32 * nb;
    const int ns = (is_win && n0 == 5120) ? 3072 : n0 + ((is_win && n0 >= 3072) ? 16 : 0);
#pragma unroll 8
    for (int i = 0; i < 32; ++i) { const int kk = 2 * i + (lane >> 5); scr[kk * 33 + (lane & 31)] = W[(size_t)(k0 + kk) * ldw + ns + (lane & 31)] * (kscale ? kscale[k0 + kk] : 1.f); }
    LDS_WAIT();
    const int c = lane & 7;
#pragma unroll
    for (int j = 0; j < 4; ++j) { const int n = (lane >> 3) + 8 * j; const LAS float* s = scr + (8 * c) * 33 + n;
        u32x4 o; o.x = cvt_pk_bf16(s[0 * 33], s[1 * 33]); o.y = cvt_pk_bf16(s[2 * 33], s[3 * 33]); o.z = cvt_pk_bf16(s[4 * 33], s[5 * 33]); o.w = cvt_pk_bf16(s[6 * 33], s[7 * 33]);
        *(u32x4*)(WT + (size_t)(n0 + n) * K + k0 + 8 * c) = o; }
    LDS_WAIT();
}

__device__ __forceinline__ void phase0(const Params& p, LAS unsigned char* lds) {
    const int tid = opaque_tid(), lane = tid & 63, wave = tid >> 6;
    const int gw = blockIdx.x * 8 + wave, NGW = gridDim.x * 8;
    LAS float* scr = (LAS float*)(lds + wave * 8704);
    bf16_t* wtin = (bf16_t*)(p.ws + OFF_WTIN); bf16_t* wtout = (bf16_t*)(p.ws + OFF_WTOUT); bf16_t* wtq = (bf16_t*)(p.ws + OFF_WTQ);
    for (int it = gw; it < 4624; it += NGW) {
        if (it < 2576) transpose_item(p.w_in, DIN, 1024, wtin, 161, it, lane, scr, true);
        else if (it < 3600) transpose_item(p.w_out, 1024, 2048, wtout, 32, it - 2576, lane, scr, false);
        else transpose_item(p.w_query, 2048, 1024, wtq, 64, it - 3600, lane, scr, false, p.norm_ffn_w);
    }
    {
        bf16_t* keys = (bf16_t*)(p.ws + OFF_KEYS);
        const int gt = blockIdx.x * NTHREADS + tid, NGT = gridDim.x * NTHREADS;
        for (int c = gt; c < 65536; c += NGT) {
            const int half = c >> 15, e = (c & 32767) * 4, h = e >> 14;
            const f32x4 v = *(const f32x4*)((half ? p.keys2 : p.keys1) + e);
            u32x2 o; o.x = cvt_pk_bf16(v[0], v[1]); o.y = cvt_pk_bf16(v[2], v[3]);
            *(u32x2*)(keys + e + (h + half) * 16384) = o;
        }
    }
    bf16_t* U = (bf16_t*)(p.ws + OFF_U);
    f32x4 wv[4];
#pragma unroll
    for (int j = 0; j < 4; ++j) wv[j] = *(const f32x4*)(p.norm_mix_w + 4 * (lane + 64 * j));
    for (int r = gw; r < R; r += NGW) {
        const float* src = r < NMETA ? p.meta + (size_t)r * DM : p.x + (size_t)(r - NMETA) * DM;
        f32x4 v[4]; float ss = 0.f;
#pragma unroll
        for (int j = 0; j < 4; ++j) { v[j] = *(const f32x4*)(src + 4 * (lane + 64 * j)); ss += v[j][0] * v[j][0] + v[j][1] * v[j][1] + v[j][2] * v[j][2] + v[j][3] * v[j][3]; }
        ss = wave_sum(ss);
        const float rs = rsqrtf(ss * (1.f / DM) + EPS);
#pragma unroll
        for (int j = 0; j < 4; ++j) {
            v[j] = v[j] * rs * wv[j];
            u32x2 o; o.x = cvt_pk_bf16(v[j][0], v[j][1]); o.y = cvt_pk_bf16(v[j][2], v[j][3]);
            *(u32x2*)(U + (size_t)r * DM + 4 * (lane + 64 * j)) = o;
        }
    }
}

__device__ __forceinline__ void phase1_meta(const Params& p) {
    const int tid = opaque_tid(), lane = tid & 63, wave = tid >> 6;
    const int gw = blockIdx.x * 8 + wave, NGW = gridDim.x * 8;
    const bf16_t* U = (const bf16_t*)(p.ws + OFF_U); const bf16_t* wt = (const bf16_t*)(p.ws + OFF_WTIN); bf16_t* XC = (bf16_t*)(p.ws + OFF_XC);
    float* dtraw = (float*)(p.ws + OFF_DTRAW);
    for (int it = gw; it < 256 + R / 16; it += NGW) {
        const bool is_dt = it >= 256;
        const int n0 = is_dt ? 4096 : it * 16, m0 = is_dt ? (it - 256) * 16 : 0;
        f32x4 acc = {0.f, 0.f, 0.f, 0.f};
        const bf16_t* ap = U + (size_t)(m0 + (lane & 15)) * DM + 8 * (lane >> 4);
        const bf16_t* bp = wt + (size_t)(1024 + n0 + (lane & 15)) * DM + 8 * (lane >> 4);
#pragma unroll 8
        for (int ks = 0; ks < 32; ++ks) { const bf16x8 a = *(const bf16x8*)(ap + 32 * ks), b = *(const bf16x8*)(bp + 32 * ks);
            acc = __builtin_amdgcn_mfma_f32_16x16x32_bf16(b, a, acc, 0, 0, 0); }
        if (is_dt) *(f32x4*)(dtraw + (size_t)(m0 + (lane & 15)) * 16 + 4 * (lane >> 4)) = acc;
        else { u32x2 o; o.x = cvt_pk_bf16(acc[0], acc[1]); o.y = cvt_pk_bf16(acc[2], acc[3]);
            *(u32x2*)(XC + (size_t)(lane & 15) * 4096 + n0 + 4 * (lane >> 4)) = o; }
    }
}

__device__ __forceinline__ int rowidx(int b, int s) { return s >= 0 ? NMETA + b * SEQ + s : s + NMETA; }

__device__ __forceinline__ void phase2(const Params& p, LAS unsigned char* lds) {
    const int tid = opaque_tid(), lane = tid & 63, wave = tid >> 6;
    LAS float* red = (LAS float*)lds;
    LAS float* tot = red + 128;
    const bf16_t* XC = (const bf16_t*)(p.ws + OFF_XC);
    bf16_t* YCONF = (bf16_t*)(p.ws + OFF_U);
    bf16_t* XBCC = (bf16_t*)p.out;
    bf16_t* XBCM = (bf16_t*)(p.ws + OFF_XBCM);
    constexpr int TS = 8;
    for (int item = blockIdx.x; item < 256; item += gridDim.x) {
        const int b = item >> 5, s0 = (item & 31) * 64;
        {
            const int c0 = 2 * tid;
            LAS f32x2* wl = (LAS f32x2*)(lds + 1024) + tid;
#pragma unroll
            for (int k = 0; k < 31; ++k) wl[k * 512] = *(const f32x2*)(p.conf_w + k * 1024 + c0);
            const f32x2 cb = *(const f32x2*)(p.conf_b + c0), lg = *(const f32x2*)(p.ln_g + c0), lb = *(const f32x2*)(p.ln_b + c0);
            const bool b0 = lane & 1, b1 = lane & 2, b2 = lane & 4, b3 = lane & 8;
            const int sidx = (b0 ? 8 : 0) + (b1 ? 4 : 0) + (b2 ? 2 : 0) + (b3 ? 1 : 0);
            f32x2 win[30 + TS];
            unsigned ra[TS], rg[TS];
#define RAW_LOAD(step_) do { _Pragma("unroll") for (int _i = 0; _i < TS; ++_i) { int _s = s0 + (step_) * TS + _i; _s = _s < -NMETA ? -NMETA : _s; \
            const bf16_t* _rp = XC + (size_t)rowidx(b, _s) * 4096 + 2048 + c0; ra[_i] = *(const unsigned*)_rp; rg[_i] = *(const unsigned*)(_rp + 1024); } } while (0)
#pragma unroll
            for (int i = 0; i < 30; ++i) win[i] = (f32x2){0.f, 0.f};
            RAW_LOAD(-32 / TS);
#pragma unroll 1
            for (int step = -32 / TS; step < 64 / TS; ++step) {
#pragma unroll
                for (int i = 0; i < TS; ++i) { const bool ok = (s0 + step * TS + i) >= -NMETA;
                    win[30 + i] = ok ? (f32x2){bf_lo(ra[i]) * sigmoidf_(bf_lo(rg[i])), bf_hi(ra[i]) * sigmoidf_(bf_hi(rg[i]))} : (f32x2){0.f, 0.f}; }
                if (step + 1 < 64 / TS) RAW_LOAD(step + 1);
                if (step >= 0) {
                    f32x2 h[TS];
#pragma unroll
                    for (int i = 0; i < TS; ++i) h[i] = cb;
#pragma unroll
                    for (int k = 0; k < 31; ++k) { const f32x2 w = wl[k * 512];
#pragma unroll
                        for (int i = 0; i < TS; ++i) h[i] += w * win[i + k]; }
                    float st[16];
#pragma unroll
                    for (int i = 0; i < TS; ++i) { st[2 * i] = h[i][0] + h[i][1]; st[2 * i + 1] = h[i][0] * h[i][0] + h[i][1] * h[i][1]; }
                    float r8[8], r4[4], r2[2], r1;
#pragma unroll
                    for (int i = 0; i < 8; ++i) { const float send = b0 ? st[i] : st[i + 8], keep = b0 ? st[i + 8] : st[i];
                        r8[i] = keep + __int_as_float(__builtin_amdgcn_update_dpp(0, __float_as_int(send), 0xB1, 0xf, 0xf, false)); }
#pragma unroll
                    for (int i = 0; i < 4; ++i) { const float send = b1 ? r8[i] : r8[i + 4], keep = b1 ? r8[i + 4] : r8[i];
                        r4[i] = keep + __int_as_float(__builtin_amdgcn_update_dpp(0, __float_as_int(send), 0x4E, 0xf, 0xf, false)); }
#pragma unroll
                    for (int i = 0; i < 2; ++i) { const float send = b2 ? r4[i] : r4[i + 2], keep = b2 ? r4[i + 2] : r4[i]; r2[i] = keep + swz_xor(send, 0x101F); }
                    { const float send = b3 ? r2[0] : r2[1], keep = b3 ? r2[1] : r2[0]; r1 = keep + swz_xor(send, 0x201F); }
                    r1 += swz_xor(r1, 0x401F); r1 += __shfl_xor(r1, 32);
                    __syncthreads();
                    if (lane < 16) red[wave * 16 + sidx] = r1;
                    __syncthreads();
                    if (tid < 16) { float a = 0.f;
#pragma unroll
                        for (int w = 0; w < 8; ++w) a += red[w * 16 + tid];
                        tot[tid] = a; }
                    __syncthreads();
#pragma unroll
                    for (int i = 0; i < TS; ++i) {
                        const float mu = tot[2 * i] * (1.f / 1024.f), var = tot[2 * i + 1] * (1.f / 1024.f) - mu * mu, rstd = rsqrtf(var + EPS);
                        const float y0 = (h[i][0] - mu) * rstd * lg[0] + lb[0], y1 = (h[i][1] - mu) * rstd * lg[1] + lb[1];
                        const int t = b * SEQ + s0 + step * TS + i;
                        *(unsigned*)(YCONF + (size_t)t * DM + c0) = cvt_pk_bf16(siluf_(y0), siluf_(y1));
                    }
                }
#pragma unroll
                for (int i = 0; i < 30; ++i) win[i] = win[i + TS];
            }
#undef RAW_LOAD
        }
        {
            const int c = 4 * tid;
            f32x4 w4[4];
#pragma unroll
            for (int k = 0; k < 4; ++k) w4[k] = *(const f32x4*)(p.ssd_conv_w + k * 2048 + c);
            const f32x4 bb = *(const f32x4*)(p.ssd_conv_b + c);
#define X4_LOAD(dst, row_) do { const u32x2 _v = *(const u32x2*)(XC + (size_t)(row_) * 4096 + c); dst = (f32x4){bf_lo(_v.x), bf_hi(_v.x), bf_lo(_v.y), bf_hi(_v.y)}; } while (0)
            f32x4 x0, x1, x2, x3;
            X4_LOAD(x0, rowidx(b, s0 - 3)); X4_LOAD(x1, rowidx(b, s0 - 2)); X4_LOAD(x2, rowidx(b, s0 - 1));
#pragma unroll 1
            for (int i0 = 0; i0 < 64; i0 += 8) {
                u32x2 rw[8];
#pragma unroll
                for (int i = 0; i < 8; ++i) rw[i] = *(const u32x2*)(XC + (size_t)(NMETA + b * SEQ + s0 + i0 + i) * 4096 + c);
#pragma unroll
                for (int i = 0; i < 8; ++i) {
                    x3 = (f32x4){bf_lo(rw[i].x), bf_hi(rw[i].x), bf_lo(rw[i].y), bf_hi(rw[i].y)};
                    f32x4 a = bb + w4[0] * x0 + w4[1] * x1 + w4[2] * x2 + w4[3] * x3;
                    u32x2 o; o.x = cvt_pk_bf16(siluf_(a[0]), siluf_(a[1])); o.y = cvt_pk_bf16(siluf_(a[2]), siluf_(a[3]));
                    *(u32x2*)(XBCC + (size_t)(b * SEQ + s0 + i0 + i) * 2048 + c) = o;
                    x0 = x1; x1 = x2; x2 = x3;
                }
            }
            if (item == 0) {
                x0 = (f32x4){0.f, 0.f, 0.f, 0.f}; x1 = x0; x2 = x0;
#pragma unroll 4
                for (int l = 0; l < NMETA; ++l) {
                    X4_LOAD(x3, l);
                    f32x4 a = bb + w4[0] * x0 + w4[1] * x1 + w4[2] * x2 + w4[3] * x3;
                    u32x2 o; o.x = cvt_pk_bf16(siluf_(a[0]), siluf_(a[1])); o.y = cvt_pk_bf16(siluf_(a[2]), siluf_(a[3]));
                    *(u32x2*)(XBCM + (size_t)l * 2048 + c) = o;
                    x0 = x1; x1 = x2; x2 = x3;
                }
            }
#undef X4_LOAD
        }
    }
}

__device__ __forceinline__ bf16x8 tr_read8(unsigned base, const int off0, const int off1) {
    u32x2 lo, hi;
    asm volatile("ds_read_b64_tr_b16 %0, %2 offset:%3\n\tds_read_b64_tr_b16 %1, %2 offset:%4\n\ts_waitcnt lgkmcnt(0)" : "=&v"(lo), "=&v"(hi) : "v"(base), "i"(off0), "i"(off1) : "memory");
    u32x4 r; r.x = lo.x; r.y = lo.y; r.z = hi.x; r.w = hi.y;
    return __builtin_bit_cast(bf16x8, r);
}
__device__ __forceinline__ void ssd_dt_scan(const Params& p, LAS float* acs, LAS float* dtv, LAS float* wtot, int row0, int g) {
    const int tid = opaque_tid(), lane = tid & 63, wave = tid >> 6, r = tid >> 7, l = tid & 127, h = 4 * g + r;
    const float* dtraw = (const float*)(p.ws + OFF_DTRAW);
    const float dt = softplusf_(dtraw[(size_t)(row0 + l) * 16 + h] + p.dt_bias[h]);
    const float aneg = -__expf(p.A_log[h]);
    float v = dt * aneg;
#pragma unroll
    for (int o = 1; o < 64; o <<= 1) { const float n = __shfl_up(v, o); if (lane >= o) v += n; }
    if (lane == 63) wtot[wave] = v;
    __syncthreads();
    if (wave & 1) v += wtot[wave - 1];
    acs[r * 128 + l] = v; dtv[r * 128 + l] = dt;
    __syncthreads();
}

__device__ __forceinline__ void phase3(const Params& p, LAS unsigned char* lds) {
    const int tid = opaque_tid(), lane = tid & 63, wave = __builtin_amdgcn_readfirstlane(tid >> 6);
    LAS float* acs = (LAS float*)lds; LAS float* dtv = acs + 512; LAS float* wtot = dtv + 512;
    constexpr int XS_OFF = 4352, XS_STRIDE = 544, BS_OFF = XS_OFF + 128 * XS_STRIDE, BS_STRIDE = 288;
    const bf16_t* XBCC = (const bf16_t*)p.out;
    bf16_t* ST = (bf16_t*)(p.ws + OFF_ST); float* CDEC = (float*)(p.ws + OFF_CDEC);
    const unsigned lbase = (unsigned)(uintptr_t)lds;
    for (int item = blockIdx.x; item < 512; item += gridDim.x) {
        const int g = item & 3, c = (item >> 2) & 15, b = item >> 6;
        const int t0 = b * SEQ + c * 128;
        u32x4 xr[8], br[4];
#pragma unroll
        for (int ps = 0; ps < 8; ++ps) xr[ps] = *(const u32x4*)(XBCC + (size_t)(t0 + ps * 16 + (tid >> 5)) * 2048 + g * 256 + (tid & 31) * 8);
#pragma unroll
        for (int ps = 0; ps < 4; ++ps) br[ps] = *(const u32x4*)(XBCC + (size_t)(t0 + ps * 32 + (tid >> 4)) * 2048 + 1024 + g * 128 + (tid & 15) * 8);
        ssd_dt_scan(p, acs, dtv, wtot, NMETA + t0, g);
        { float* ap = (float*)(p.ws + OFF_ACS) + (size_t)item * 1024; ap[tid] = acs[tid]; ap[512 + tid] = dtv[tid]; }
        if (tid < 4) CDEC[(b * 16 + c) * 16 + 4 * g + tid] = __expf(acs[tid * 128 + 127]);
#pragma unroll
        for (int ps = 0; ps < 8; ++ps) {
            const int row = ps * 16 + (tid >> 5), ch = tid & 31, r = ch >> 3;
            const u32x4 v = xr[ps];
            const float sc = dtv[r * 128 + row] * __expf(acs[r * 128 + 127] - acs[r * 128 + row]);
            u32x4 o; o.x = cvt_pk_bf16(bf_lo(v.x) * sc, bf_hi(v.x) * sc); o.y = cvt_pk_bf16(bf_lo(v.y) * sc, bf_hi(v.y) * sc);
            o.z = cvt_pk_bf16(bf_lo(v.z) * sc, bf_hi(v.z) * sc); o.w = cvt_pk_bf16(bf_lo(v.w) * sc, bf_hi(v.w) * sc);
            *(LAS u32x4*)(lds + XS_OFF + row * XS_STRIDE + ch * 16) = o;
        }
#pragma unroll
        for (int ps = 0; ps < 4; ++ps) { const int row = ps * 32 + (tid >> 4), ch = tid & 15; *(LAS u32x4*)(lds + BS_OFF + row * BS_STRIDE + ch * 16) = br[ps]; }
        __syncthreads();
        f32x4 acc[4][4];
#pragma unroll
        for (int r = 0; r < 4; ++r)
#pragma unroll
            for (int mt = 0; mt < 4; ++mt) acc[r][mt] = (f32x4){0.f, 0.f, 0.f, 0.f};
        const int gid = lane >> 4, q = (lane & 15) >> 2, pp = lane & 3;
const unsigned bbase = lbase + BS_OFF + (8 * gid + q) * BS_STRIDE + (16 * wave + 4 * pp) * 2;
        const unsigned xbase = lbase + XS_OFF + (8 * gid + q) * XS_STRIDE + (4 * pp) * 2;
#pragma unroll
        for (int ks = 0; ks < 4; ++ks) {
            const bf16x8 bfrag = tr_read8(bbase, 32 * ks * BS_STRIDE, 32 * ks * BS_STRIDE + 4 * BS_STRIDE);
#pragma unroll
            for (int r = 0; r < 4; ++r)
#pragma unroll
                for (int mt = 0; mt < 4; ++mt) {
                    const bf16x8 xfrag = tr_read8(xbase, 32 * ks * XS_STRIDE + (r * 64 + 16 * mt) * 2, 32 * ks * XS_STRIDE + (r * 64 + 16 * mt) * 2 + 4 * XS_STRIDE);
                    acc[r][mt] = __builtin_amdgcn_mfma_f32_16x16x32_bf16(bfrag, xfrag, acc[r][mt], 0, 0, 0);
                }
        }
#pragma unroll
        for (int r = 0; r < 4; ++r)
#pragma unroll
            for (int mt = 0; mt < 4; ++mt)
                { u32x2 o; o.x = cvt_pk_bf16(acc[r][mt][0], acc[r][mt][1]); o.y = cvt_pk_bf16(acc[r][mt][2], acc[r][mt][3]);
                  *(u32x2*)(ST + ((size_t)((b * 16 + c) * 16 + 4 * g + r) * 64 + 16 * mt + (lane & 15)) * 128 + 16 * wave + 4 * (lane >> 4)) = o; }
        __syncthreads();
    }
}

__device__ __forceinline__ void phase4(const Params& p) {
    const int gt = blockIdx.x * NTHREADS + opaque_tid(), NGT = gridDim.x * NTHREADS;
    bf16_t* ST = (bf16_t*)(p.ws + OFF_ST); const float* CDEC = (const float*)(p.ws + OFF_CDEC);
    const bf16_t* XBCM = (const bf16_t*)(p.ws + OFF_XBCM); const float* dtraw = (const float*)(p.ws + OFF_DTRAW);
    for (int e = gt; e < NB * 16 * 64 * 32; e += NGT) {
        const int n4 = e & 31, pq = (e >> 5) & 63, h = (e >> 11) & 15, b = e >> 15, g = h >> 2;
        const float aneg = -__expf(p.A_log[h]), bias = p.dt_bias[h];
        f32x4 run = {0.f, 0.f, 0.f, 0.f}; float suf = 0.f;
        for (int l = NMETA - 1; l >= 0; --l) {
            const float dt = softplusf_(dtraw[l * 16 + h] + bias);
            const float w = dt * __expf(suf) * __uint_as_float((unsigned)XBCM[l * 2048 + h * 64 + pq] << 16);
            const u32x2 bv = *(const u32x2*)(XBCM + l * 2048 + 1024 + g * 128 + 4 * n4);
            run += w * (f32x4){bf_lo(bv.x), bf_hi(bv.x), bf_lo(bv.y), bf_hi(bv.y)};
            suf += dt * aneg;
        }
        bf16_t* sp = ST + ((size_t)(b * 16 * 16 + h) * 64 + pq) * 128 + 4 * n4;
        u32x2 sv[16];
#pragma unroll
        for (int c = 0; c < 16; ++c) sv[c] = *(const u32x2*)(sp + (size_t)c * 16 * 64 * 128);
#pragma unroll
        for (int c = 0; c < 16; ++c) {
            u32x2 o; o.x = cvt_pk_bf16(run[0], run[1]); o.y = cvt_pk_bf16(run[2], run[3]);
            *(u32x2*)(sp + (size_t)c * 16 * 64 * 128) = o;
            run = run * CDEC[(b * 16 + c) * 16 + h] + (f32x4){bf_lo(sv[c].x), bf_hi(sv[c].x), bf_lo(sv[c].y), bf_hi(sv[c].y)};
        }
    }
}

__device__ __forceinline__ void phase5(const Params& p, LAS unsigned char* lds) {
    const int tid = opaque_tid(), lane = tid & 63, wave = __builtin_amdgcn_readfirstlane(tid >> 6);
    LAS float* acs = (LAS float*)lds; LAS float* dtv = acs + 512; LAS float* wtot = dtv + 512;
    constexpr int TS = 288;
    constexpr int CS_OFF = 4352, BM_OFF = CS_OFF + 128 * TS, XS_OFF = BM_OFF + 128 * TS, XS_STRIDE = 144, PS_OFF = XS_OFF + 128 * XS_STRIDE;
    const bf16_t* XBCC = (const bf16_t*)p.out; const bf16_t* Z = (const bf16_t*)(p.ws + OFF_Z);
    const bf16_t* ST = (const bf16_t*)(p.ws + OFF_ST); bf16_t* YSSD = (bf16_t*)(p.ws + OFF_YSSD);
    const unsigned lbase = (unsigned)(uintptr_t)lds;
    const int fr = lane & 15, fq = lane >> 4;
    for (int item = blockIdx.x; item < 512; item += gridDim.x) {
        const int g = item & 3, c = (item >> 2) & 15, b = item >> 6;
        const int t0 = b * SEQ + c * 128;
        u32x4 brr[4], crr[4];
#pragma unroll
        for (int ps = 0; ps < 4; ++ps) { const bf16_t* rp = XBCC + (size_t)(t0 + ps * 32 + (tid >> 4)) * 2048 + 1024 + g * 128 + (tid & 15) * 8; brr[ps] = *(const u32x4*)rp; crr[ps] = *(const u32x4*)(rp + 512); }
        u32x4 xq[2], pq4[2];
#define P5_PREFETCH(r_) do { const int _h = 4 * g + (r_); _Pragma("unroll") for (int _ps = 0; _ps < 2; ++_ps) { \
            xq[_ps] = *(const u32x4*)(XBCC + (size_t)(t0 + _ps * 64 + (tid >> 3)) * 2048 + _h * 64 + (tid & 7) * 8); \
            const int _e = _ps * 512 + tid; pq4[_ps] = *(const u32x4*)(ST + ((size_t)((b * 16 + c) * 16 + _h) * 64 + (_e >> 4)) * 128 + 8 * (_e & 15)); } } while (0)
        P5_PREFETCH(0);
        { const float* ap = (const float*)(p.ws + OFF_ACS) + (size_t)item * 1024; acs[tid] = ap[tid]; dtv[tid] = ap[512 + tid]; }
#pragma unroll
        for (int ps = 0; ps < 4; ++ps) { const int row = ps * 32 + (tid >> 4), ch = tid & 15;
            *(LAS u32x4*)(lds + BM_OFF + row * TS + ch * 16) = brr[ps]; *(LAS u32x4*)(lds + CS_OFF + row * TS + ch * 16) = crr[ps]; }
        __syncthreads();
        f32x4 cb[8];
#pragma unroll
        for (int nt = 0; nt < 8; ++nt) cb[nt] = (f32x4){0.f, 0.f, 0.f, 0.f};
        bf16x8 cfrag[4];
#pragma unroll
        for (int ks = 0; ks < 4; ++ks) cfrag[ks] = *(const LAS bf16x8*)(lds + CS_OFF + (16 * wave + fr) * TS + (32 * ks + 8 * fq) * 2);
#pragma unroll
        for (int nt = 0; nt < 8; ++nt)
#pragma unroll
            for (int ks = 0; ks < 4; ++ks) { const bf16x8 bfrag = *(const LAS bf16x8*)(lds + BM_OFF + (16 * nt + fr) * TS + (32 * ks + 8 * fq) * 2);
                cb[nt] = __builtin_amdgcn_mfma_f32_16x16x32_bf16(bfrag, cfrag[ks], cb[nt], 0, 0, 0); }
        __syncthreads();
        f32x4 y[4][4];
        const int l = 16 * wave + fr;
#pragma unroll
        for (int r = 0; r < 4; ++r) {
            const int h = 4 * g + r;
            const float al = acs[r * 128 + l];
#pragma unroll
            for (int nt = 0; nt < 8; ++nt) { const int s = 16 * nt + 4 * fq; float m[4];
#pragma unroll
                for (int j = 0; j < 4; ++j) m[j] = (s + j <= l) ? cb[nt][j] * __expf(al - acs[r * 128 + s + j]) : 0.f;
                u32x2 o; o.x = cvt_pk_bf16(m[0], m[1]); o.y = cvt_pk_bf16(m[2], m[3]);
                *(LAS u32x2*)(lds + BM_OFF + l * TS + s * 2) = o; }
#pragma unroll
            for (int ps = 0; ps < 2; ++ps) { const int row = ps * 64 + (tid >> 3), ch = tid & 7;
                const u32x4 v = xq[ps]; const float sc = dtv[r * 128 + row];
                u32x4 o; o.x = cvt_pk_bf16(bf_lo(v.x) * sc, bf_hi(v.x) * sc); o.y = cvt_pk_bf16(bf_lo(v.y) * sc, bf_hi(v.y) * sc);
                o.z = cvt_pk_bf16(bf_lo(v.z) * sc, bf_hi(v.z) * sc); o.w = cvt_pk_bf16(bf_lo(v.w) * sc, bf_hi(v.w) * sc);
                *(LAS u32x4*)(lds + XS_OFF + row * XS_STRIDE + ch * 16) = o;
                const int e = ps * 512 + tid; *(LAS u32x4*)(lds + PS_OFF + (e >> 4) * TS + (e & 15) * 16) = pq4[ps]; }
            if (r < 3) P5_PREFETCH(r + 1);
            __syncthreads();
#pragma unroll
            for (int mt = 0; mt < 4; ++mt) { f32x4 a = {0.f, 0.f, 0.f, 0.f};
#pragma unroll
                for (int ks = 0; ks < 4; ++ks) { const bf16x8 pf = *(const LAS bf16x8*)(lds + PS_OFF + (16 * mt + fr) * TS + (32 * ks + 8 * fq) * 2);
                    a = __builtin_amdgcn_mfma_f32_16x16x32_bf16(pf, cfrag[ks], a, 0, 0, 0); }
                y[r][mt] = a * __expf(al); }
            {
                const int q = fr >> 2, pp = lane & 3;
                const unsigned xbase = lbase + XS_OFF + (8 * fq + q) * XS_STRIDE + (4 * pp) * 2;
#pragma unroll
                for (int ks = 0; ks < 4; ++ks) {
                    const bf16x8 mf = *(const LAS bf16x8*)(lds + BM_OFF + l * TS + (32 * ks + 8 * fq) * 2);
#pragma unroll
                    for (int mt = 0; mt < 4; ++mt) { const bf16x8 xf = tr_read8(xbase, 32 * ks * XS_STRIDE + 32 * mt, 32 * ks * XS_STRIDE + 32 * mt + 4 * XS_STRIDE);
                        y[r][mt] = __builtin_amdgcn_mfma_f32_16x16x32_bf16(xf, mf, y[r][mt], 0, 0, 0); }
                }
            }
            __syncthreads();
        }
#undef P5_PREFETCH
        const size_t t = (size_t)(t0 + l);
        float ss = 0.f;
#pragma unroll
        for (int r = 0; r < 4; ++r) { const float dsk = p.Dskip[4 * g + r];
#pragma unroll
            for (int mt = 0; mt < 4; ++mt) { const int ch = (4 * g + r) * 64 + 16 * mt + 4 * fq;
                const u32x2 xv = *(const u32x2*)(XBCC + t * 2048 + ch); const u32x2 zv = *(const u32x2*)(Z + t * DM + ch);
                f32x4 v = y[r][mt];
                v[0] = (v[0] + dsk * bf_lo(xv.x)) * siluf_(bf_lo(zv.x)); v[1] = (v[1] + dsk * bf_hi(xv.x)) * siluf_(bf_hi(zv.x));
                v[2] = (v[2] + dsk * bf_lo(xv.y)) * siluf_(bf_lo(zv.y)); v[3] = (v[3] + dsk * bf_hi(xv.y)) * siluf_(bf_hi(zv.y));
                ss += v[0] * v[0] + v[1] * v[1] + v[2] * v[2] + v[3] * v[3]; y[r][mt] = v; } }
        ss += xor16f(ss); ss += __int_as_float(xor32i(__float_as_int(ss), lane));
        const float rs = rsqrtf(ss * (1.f / 256.f) + EPS);
#pragma unroll
        for (int r = 0; r < 4; ++r)
#pragma unroll
            for (int mt = 0; mt < 4; ++mt) { const int ch = (4 * g + r) * 64 + 16 * mt + 4 * fq; const f32x4 nw = *(const f32x4*)(p.ssd_norm_w + ch); const f32x4 v = y[r][mt] * rs * nw;
                u32x2 o; o.x = cvt_pk_bf16(v[0], v[1]); o.y = cvt_pk_bf16(v[2], v[3]); *(u32x2*)(YSSD + t * DM + ch) = o; }
    }
}

__device__ __forceinline__ void phase7(const Params& p) {
    const int tid = opaque_tid(), lane = tid & 63, wave = tid >> 6;
    const int gw = blockIdx.x * 8 + wave, NGW = gridDim.x * 8;
    const float* H1 = (const float*)(p.ws + OFF_H1); bf16_t* U2 = (bf16_t*)(p.ws + OFF_Z);
    f32x4 wv[4];
#pragma unroll
    for (int j = 0; j < 4; ++j) wv[j] = *(const f32x4*)(p.norm_ffn_w + 4 * (lane + 64 * j));
    for (int r = gw; r < T; r += NGW) {
        f32x4 v[4]; float ss = 0.f;
#pragma unroll
        for (int j = 0; j < 4; ++j) { v[j] = *(const f32x4*)(H1 + (size_t)r * DM + 4 * (lane + 64 * j)); ss += v[j][0] * v[j][0] + v[j][1] * v[j][1] + v[j][2] * v[j][2] + v[j][3] * v[j][3]; }
        ss = wave_sum(ss);
        const float rs = rsqrtf(ss * (1.f / DM) + EPS);
#pragma unroll
        for (int j = 0; j < 4; ++j) { v[j] = v[j] * rs * wv[j]; u32x2 o; o.x = cvt_pk_bf16(v[j][0], v[j][1]); o.y = cvt_pk_bf16(v[j][2], v[j][3]);
            *(u32x2*)(U2 + (size_t)r * DM + 4 * (lane + 64 * j)) = o; }
    }
}

__device__ __forceinline__ void convert_tables(const Params& p, int tid) {
    const int gt = blockIdx.x * NTHREADS + tid, NGT = gridDim.x * NTHREADS;
    unsigned char* WD4 = p.ws + OFF_WD;
    unsigned char* WU8 = p.ws + OFF_WU;
    for (int c = gt; c < 2 * 16384 * 64; c += NGT) {
        const int which = c >> 20; const int cc = c & 1048575; const size_t e = (size_t)cc * 16;
        const float* src = (which ? p.w_up : p.w_down) + e;
        f32x4 a[4];
#pragma unroll
        for (int q = 0; q < 4; ++q) a[q] = *(const f32x4*)(src + 4 * q);
        {
            float mx = 0.f;
#pragma unroll
            for (int q = 0; q < 4; ++q) mx = fmaxf(fmaxf(fmaxf(fabsf(a[q][0]), fabsf(a[q][1])), fmaxf(fabsf(a[q][2]), fabsf(a[q][3]))), mx);
            const unsigned sb = cvt_pk_bf16(fmaxf(mx, 1e-30f) * (1.f / 6.f), 0.f) & 0xffffu;
            const float inv = __builtin_amdgcn_rcpf(__uint_as_float(sb << 16));
            u32x2 o;
#pragma unroll
            for (int d = 0; d < 2; ++d) { unsigned pk = 0u;
                pk = __builtin_amdgcn_cvt_scalef32_pk_fp4_f32(pk, a[2 * d][0] * inv, a[2 * d][1] * inv, 1.0f, 0);
                pk = __builtin_amdgcn_cvt_scalef32_pk_fp4_f32(pk, a[2 * d][2] * inv, a[2 * d][3] * inv, 1.0f, 1);
                pk = __builtin_amdgcn_cvt_scalef32_pk_fp4_f32(pk, a[2 * d + 1][0] * inv, a[2 * d + 1][1] * inv, 1.0f, 2);
                pk = __builtin_amdgcn_cvt_scalef32_pk_fp4_f32(pk, a[2 * d + 1][2] * inv, a[2 * d + 1][3] * inv, 1.0f, 3);
                o[d] = pk; }
            const int row = cc >> 6, ln = cc & 63;
            unsigned char* T4 = which ? WU8 : WD4;
            *(u32x2*)(T4 + (size_t)row * 640 + 8 * ln) = o;
            *(unsigned short*)(T4 + (size_t)row * 640 + 512 + 2 * ln) = (unsigned short)sb;
        }
    }
}

__device__ __forceinline__ int f2sort(float f) { const int b = __float_as_int(f); return b ^ ((b >> 31) & 0x7fffffff); }
__device__ __forceinline__ float sort2f(int s) { return __int_as_float(s ^ ((s >> 31) & 0x7fffffff)); }
#define CE_DESC(x, y) do { const int _hi = max(x, y), _lo = min(x, y); x = _hi; y = _lo; } while (0)
__device__ __forceinline__ void sort16_desc(int (&v)[16]) {
#pragma unroll
    for (int k = 2; k <= 16; k <<= 1)
#pragma unroll
        for (int j = k >> 1; j > 0; j >>= 1)
#pragma unroll
            for (int i = 0; i < 16; ++i) { const int l = i ^ j; if (l > i) { if ((i & k) == 0) CE_DESC(v[i], v[l]); else CE_DESC(v[l], v[i]); } }
}
__device__ __forceinline__ void merge_top16(int (&a)[16], const int (&b)[16]) {
#pragma unroll
    for (int i = 0; i < 16; ++i) a[i] = max(a[i], b[15 - i]);
#pragma unroll
    for (int j = 8; j > 0; j >>= 1)
#pragma unroll
        for (int i = 0; i < 16; ++i) if ((i & j) == 0) CE_DESC(a[i], a[i + j]);
}
#define CE_INSERT(arr, val) do { int _v = (val); _Pragma("unroll") for (int _j = 0; _j < 16; ++_j) { const int _hi = max(arr[_j], _v); _v = min(arr[_j], _v); arr[_j] = _hi; } } while (0)

__device__ __forceinline__ void topk_half(const bf16_t* Q, const bf16_t* KEYS, int t0, int h, int half, int lane, int (&a)[16]) {
#pragma unroll
    for (int j = 0; j < 16; ++j) a[j] = (int)0x80000000;
    bf16x8 qf[8];
    const bf16_t* qp = Q + (size_t)(t0 + (lane & 31)) * 2048 + h * 256 + half * 128 + 8 * (lane >> 5);
#pragma unroll
    for (int ks = 0; ks < 8; ++ks) qf[ks] = *(const bf16x8*)(qp + 16 * ks);
    const int lane_off = 4 * (lane >> 5);
#pragma unroll 1
    for (int kb = 0; kb < 4; ++kb) {
        const bf16_t* kp = KEYS + (size_t)((h * 2 + half) * 128 + 32 * kb + (lane & 31)) * 128 + 8 * (lane >> 5);
        f32x16 acc;
#pragma unroll
        for (int i = 0; i < 16; ++i) acc[i] = 0.f;
#pragma unroll
        for (int ks = 0; ks < 8; ++ks) { const bf16x8 kf = *(const bf16x8*)(kp + 16 * ks); acc = __builtin_amdgcn_mfma_f32_32x32x16_bf16(kf, qf[ks], acc, 0, 0, 0); }
int nv[16];
#pragma unroll
        for (int reg = 0; reg < 16; ++reg) {
            const int low = 127 - 32 * kb - (reg & 3) - 8 * (reg >> 2) - lane_off;
            nv[reg] = (f2sort(acc[reg]) & ~127) | low;
        }
        sort16_desc(nv); merge_top16(a, nv);
    }
    int pb[16];
#pragma unroll
    for (int j = 0; j < 16; ++j) pb[j] = xor32i(a[j], lane);
    merge_top16(a, pb);
}

__device__ __forceinline__ void phase9(const Params& p, LAS unsigned char* lds) {
    const int tid = opaque_tid(), lane = tid & 63, wave = tid >> 6;
    const bf16_t* Q = (const bf16_t*)p.out; const bf16_t* KEYS = (const bf16_t*)(p.ws + OFF_KEYS);
    unsigned short* IDX = (unsigned short*)(p.ws + OFF_IDX); float* GATE = (float*)(p.ws + OFF_GATE);
    LAS unsigned char* slot = lds + wave * 2048 + lane * 32;
    if (wave & 1) convert_tables(p, tid);
    pg8::StaticOrder S; S.init(T, 2048, gridDim.x, blockIdx.x);
    pg8::Unit u;
    for (int ui = 0; S.next(ui, u); ++ui) {
        const int h = u.pn, t0 = u.pm * 256 + 32 * wave;
        int a1[16], a2[16];
        topk_half(Q, KEYS, t0, h, 0, lane, a1);
        topk_half(Q, KEYS, t0, h, 1, lane, a2);
        float v1[16], v2[16];
#pragma unroll
        for (int i = 0; i < 16; ++i) { v1[i] = sort2f(a1[i] & ~127); v2[i] = sort2f(a2[i] & ~127); slot[i] = (unsigned char)(127 - (a1[i] & 127)); slot[16 + i] = (unsigned char)(127 - (a2[i] & 127)); }
        const int hh = (lane >> 5) & 1, hm = -hh;
        float v1h[8];
#pragma unroll
        for (int k = 0; k < 8; ++k) v1h[k] = __int_as_float((__float_as_int(v1[2 * k]) & ~hm) | (__float_as_int(v1[2 * k + 1]) & hm));
        const int hoff = 16 * hh;
#define CKEY(k, j) ((f2sort(v1h[k] + v2[j]) & ~255) | (255 - (32 * (k) + (j)) - hoff))
        int cnd[16];
#pragma unroll
        for (int j = 0; j < 16; ++j) cnd[j] = CKEY(0, j);
        { int d[16];
#pragma unroll
          for (int j = 0; j < 16; ++j) d[j] = (j < 5) ? CKEY(1, j) : (int)0x80000000;
          merge_top16(cnd, d); }
        { int d[16];
          d[0] = CKEY(2, 0); d[1] = CKEY(2, 1); d[2] = CKEY(2, 2); d[3] = CKEY(3, 0); d[4] = CKEY(3, 1); d[5] = CKEY(4, 0); d[6] = CKEY(5, 0); d[7] = CKEY(6, 0); d[8] = CKEY(7, 0);
#pragma unroll
          for (int j = 9; j < 16; ++j) d[j] = (int)0x80000000;
          sort16_desc(d); merge_top16(cnd, d); }
        { int pb[16];
#pragma unroll
          for (int j = 0; j < 16; ++j) pb[j] = xor32i(cnd[j], lane);
          merge_top16(cnd, pb); }
#undef CKEY
        float ts[16], sum = 0.f; const float mx = sort2f(cnd[0] & ~255);
#pragma unroll
        for (int k = 0; k < 16; ++k) { ts[k] = __expf(sort2f(cnd[k] & ~255) - mx); sum += ts[k]; }
        const float inv = __builtin_amdgcn_rcpf(sum);
        LDS_WAIT();
        unsigned ex[16];
#pragma unroll
        for (int k = 0; k < 16; ++k) { const int pos = 255 - (cnd[k] & 255); ex[k] = (unsigned)slot[pos >> 4] * 128u + (unsigned)slot[16 + (pos & 15)]; }
        if (lane < 32) {
            const size_t o = ((size_t)(t0 + lane) * 8 + h) * 16;
            u32x4 w0, w1;
            w0.x = ex[0] | (ex[1] << 16); w0.y = ex[2] | (ex[3] << 16); w0.z = ex[4] | (ex[5] << 16); w0.w = ex[6] | (ex[7] << 16);
            w1.x = ex[8] | (ex[9] << 16); w1.y = ex[10] | (ex[11] << 16); w1.z = ex[12] | (ex[13] << 16); w1.w = ex[14] | (ex[15] << 16);
            *(u32x4*)(IDX + o) = w0; *(u32x4*)(IDX + o + 8) = w1;
#pragma unroll
            for (int k4 = 0; k4 < 4; ++k4) *(f32x4*)(GATE + o + 4 * k4) = (f32x4){ts[4 * k4] * inv, ts[4 * k4 + 1] * inv, ts[4 * k4 + 2] * inv, ts[4 * k4 + 3] * inv};
        }
        LDS_WAIT();
    }
    if (!(wave & 1)) convert_tables(p, tid);
}

__device__ __forceinline__ float gelu_erf(float v) {
    const float av = fabsf(v), t = __builtin_amdgcn_rcpf(av * 0.2316418882f + 1.0f);
    float q = t * 0.5307027145f + (-0.7265760135f); q = q * t + 0.7107068705f; q = q * t + (-0.142248368f); q = q * t + 0.127414796f; q = q * t;
    const float e = __builtin_amdgcn_exp2f(v * v * (-0.72134752044f));
    const float m = v * (q * e);
    return v < 0.f ? m : v - m;
}
__device__ __forceinline__ void phase10(const Params& p) {
    const int tid = opaque_tid(), lane = tid & 63, wave = tid >> 6;
    const int gw = blockIdx.x * 8 + wave, NGW = gridDim.x * 8;
    const bf16_t* U2 = (const bf16_t*)(p.ws + OFF_Z); const unsigned char* WD4 = p.ws + OFF_WD; const unsigned char* WU8 = p.ws + OFF_WU;
    const unsigned short* IDX = (const unsigned short*)(p.ws + OFF_IDX); const float* GATE = (const float*)(p.ws + OFF_GATE);
    const float* H1 = (const float*)(p.ws + OFF_H1);
    const bool b0 = lane & 1, b1 = lane & 2, b2 = lane & 4;
    const int jmap = (b0 ? 4 : 0) + (b1 ? 2 : 0) + (b2 ? 1 : 0);
    const float* ROWSS = (const float*)(p.ws + OFF_ROWSS);
    f32x2 nw[8];
#pragma unroll
    for (int q = 0; q < 8; ++q) nw[q] = *(const f32x2*)(p.norm_ffn_w + 16 * lane + 2 * q);
    for (int t = gw; t < T; t += NGW) {
        const int i0 = IDX[(size_t)t * 128 + lane], i1 = IDX[(size_t)t * 128 + 64 + lane];
        const float g0 = GATE[(size_t)t * 128 + lane] , g1 = GATE[(size_t)t * 128 + 64 + lane];
        f32x2 xv[8];
        { const u32x4 xa = *(const u32x4*)(U2 + (size_t)t * DM + 16 * lane), xb = *(const u32x4*)(U2 + (size_t)t * DM + 16 * lane + 8);
          const f32x4* rp = (const f32x4*)(ROWSS + (size_t)t * 16); const f32x4 s0 = rp[0], s1 = rp[1], s2 = rp[2], s3 = rp[3];
          const float tot = ((s0[0] + s0[1]) + (s0[2] + s0[3])) + ((s1[0] + s1[1]) + (s1[2] + s1[3])) + ((s2[0] + s2[1]) + (s2[2] + s2[3])) + ((s3[0] + s3[1]) + (s3[2] + s3[3]));
          const float rsc = rsqrtf(tot * (1.f / 1024.f) + EPS);
#pragma unroll
          for (int q = 0; q < 4; ++q) { xv[q] = (f32x2){bf_lo(xa[q]), bf_hi(xa[q])} * rsc * nw[q]; xv[4 + q] = (f32x2){bf_lo(xb[q]), bf_hi(xb[q])} * rsc * nw[4 + q]; } }
        f32x2 acc[8];
#pragma unroll
        for (int i = 0; i < 8; ++i) acc[i] = (f32x2){0.f, 0.f};
#pragma unroll 1
        for (int kk = 0; kk < 128; kk += 8) {
            u32x2 dw[8]; unsigned short dsc[8]; u32x2 uw[8]; unsigned short usc[8];
            const int isel = kk < 64 ? i0 : i1;
#pragma unroll
            for (int j = 0; j < 8; ++j) {
                const int e = __builtin_amdgcn_readlane(isel, (kk + j) & 63);
                const unsigned char* dr = WD4 + (size_t)e * 640;
                dw[j] = *(const u32x2*)(dr + 8 * lane); dsc[j] = *(const unsigned short*)(dr + 512 + 2 * lane); const unsigned char* ur = WU8 + (size_t)e * 640; uw[j] = *(const u32x2*)(ur + 8 * lane); usc[j] = *(const unsigned short*)(ur + 512 + 2 * lane);
            }
            float pd[8];
#pragma unroll
            for (int j = 0; j < 8; ++j) { f32x2 sacc = {0.f, 0.f};
#pragma unroll
                for (int d = 0; d < 2; ++d) {
                    sacc += __builtin_amdgcn_cvt_scalef32_pk_f32_fp4(dw[j][d], 1.0f, 0) * xv[4 * d]; sacc += __builtin_amdgcn_cvt_scalef32_pk_f32_fp4(dw[j][d], 1.0f, 1) * xv[4 * d + 1];
                    sacc += __builtin_amdgcn_cvt_scalef32_pk_f32_fp4(dw[j][d], 1.0f, 2) * xv[4 * d + 2]; sacc += __builtin_amdgcn_cvt_scalef32_pk_f32_fp4(dw[j][d], 1.0f, 3) * xv[4 * d + 3]; }
                pd[j] = (sacc.x + sacc.y) * __uint_as_float((unsigned)dsc[j] << 16); }
            float r4[4], r2[2], r1;
#pragma unroll
            for (int i = 0; i < 4; ++i) { const float send = b0 ? pd[i] : pd[i + 4], keep = b0 ? pd[i + 4] : pd[i];
                r4[i] = keep + __int_as_float(__builtin_amdgcn_update_dpp(0, __float_as_int(send), 0xB1, 0xf, 0xf, false)); }
#pragma unroll
            for (int i = 0; i < 2; ++i) { const float send = b1 ? r4[i] : r4[i + 2], keep = b1 ? r4[i + 2] : r4[i];
                r2[i] = keep + __int_as_float(__builtin_amdgcn_update_dpp(0, __float_as_int(send), 0x4E, 0xf, 0xf, false)); }
            { const float send = b2 ? r2[0] : r2[1], keep = b2 ? r2[1] : r2[0]; r1 = keep + swz_xor(send, 0x101F); }
            r1 += swz_xor(r1, 0x201F); r1 += swz_xor(r1, 0x401F); r1 += __shfl_xor(r1, 32);
            const int gsel = __float_as_int(kk < 64 ? g0 : g1);
            const float gel = gelu_erf(r1) * __int_as_float(__builtin_amdgcn_ds_bpermute(4 * ((kk + jmap) & 63), gsel));
#pragma unroll
            for (int j = 0; j < 8; ++j) {
                const int Lj = (j >> 2) + 2 * ((j >> 1) & 1) + 4 * (j & 1);
                const float a = __int_as_float(__builtin_amdgcn_readlane(__float_as_int(gel), Lj)) * __uint_as_float((unsigned)usc[j] << 16);
#pragma unroll
                for (int d = 0; d < 2; ++d) {
                    acc[4 * d + 0] += __builtin_amdgcn_cvt_scalef32_pk_f32_fp4(uw[j][d], 1.0f, 0) * a; acc[4 * d + 1] += __builtin_amdgcn_cvt_scalef32_pk_f32_fp4(uw[j][d], 1.0f, 1) * a;
                    acc[4 * d + 2] += __builtin_amdgcn_cvt_scalef32_pk_f32_fp4(uw[j][d], 1.0f, 2) * a; acc[4 * d + 3] += __builtin_amdgcn_cvt_scalef32_pk_f32_fp4(uw[j][d], 1.0f, 3) * a; }
            }
        }
        const float* hp = H1 + (size_t)t * DM + 16 * lane;
        f32x4 hv[4]; float ss = 0.f;
#pragma unroll
        for (int q = 0; q < 4; ++q) { hv[q] = *(const f32x4*)(hp + 4 * q); hv[q][0] += acc[2 * q][0]; hv[q][1] += acc[2 * q][1]; hv[q][2] += acc[2 * q + 1][0]; hv[q][3] += acc[2 * q + 1][1];
            ss += hv[q][0] * hv[q][0] + hv[q][1] * hv[q][1] + hv[q][2] * hv[q][2] + hv[q][3] * hv[q][3]; }
        ss = wave_sum(ss);
        const float rs = rsqrtf(ss * (1.f / DM) + EPS);
        float* op = p.out + (size_t)t * DM + 16 * lane;
#pragma unroll
        for (int q = 0; q < 4; ++q) { const f32x4 w = *(const f32x4*)(p.norm_final_w + 16 * lane + 4 * q); *(f32x4*)(op + 4 * q) = hv[q] * rs * w; }
    }
}

__global__ void __launch_bounds__(NTHREADS, 2) hymba_fwd(Params p) {
    extern __shared__ __attribute__((aligned(16))) unsigned char smem[];
    LAS unsigned char* lds = (LAS unsigned char*)smem;
    cg::grid_group grid = cg::this_grid();
    const int lo = p.ph_lo, hi = p.ph_hi;
#ifndef PH_MASK
#define PH_MASK 0x7ff
#endif
#define IN(k) (((PH_MASK >> (k)) & 1) && lo <= (k) && (k) < hi)
#define SEAM(k) do { if (IN(k) && IN((k) + 1)) { SEAM_BODY(); } } while (0)
#define SEAM_BODY() do { { \
        asm volatile("s_waitcnt vmcnt(0) lgkmcnt(0)" ::: "memory"); __syncthreads(); \
        ++bar_gen; \
        if (threadIdx.x == 0) { \
            if (bar_gen == 1u) {         \
                unsigned nx_, mine_, sum_; \
                do { nx_ = 0u; mine_ = 0u; sum_ = 0u; \
                    _Pragma("unroll") for (unsigned x_ = 0; x_ < 8; ++x_) { const unsigned c_ = __hip_atomic_load(bar + 640 + 16 * x_, __ATOMIC_RELAXED, __HIP_MEMORY_SCOPE_AGENT); sum_ += c_; nx_ += c_ > 0u ? 1u : 0u; mine_ = (x_ == my_xcc) ? c_ : mine_; } \
                    if (sum_ != gridDim.x) __builtin_amdgcn_s_sleep(1); } while (sum_ != gridDim.x); \
                xcc_n = mine_; xcc_pop = nx_; \
            } \
            { \
                const unsigned k_ = bar_gen; \
                const unsigned old_ = __hip_atomic_fetch_add(bar + 768 + 16 * my_xcc, 1u, __ATOMIC_RELAXED, __HIP_MEMORY_SCOPE_AGENT); \
                if (old_ + 1u == k_ * xcc_n) { __builtin_amdgcn_fence(__ATOMIC_RELEASE, "agent"); __hip_atomic_fetch_add(bar + 32, 1u, __ATOMIC_RELAXED, __HIP_MEMORY_SCOPE_AGENT); } \
                const unsigned target = k_ * xcc_pop; \
                while (__hip_atomic_load(bar + 32, __ATOMIC_RELAXED, __HIP_MEMORY_SCOPE_AGENT) < target) __builtin_amdgcn_s_sleep(1); \
            } \
            __builtin_amdgcn_fence(__ATOMIC_ACQUIRE, "agent"); \
            asm volatile("s_waitcnt vmcnt(0)" ::: "memory"); \
        } \
        __syncthreads(); } } while (0)
    unsigned* bar = (unsigned*)(p.ws + OFF_BAR); unsigned bar_gen = 0;
    const unsigned bar_ngrp = (gridDim.x % 8 == 0) ? 8u : 1u, bar_grp = blockIdx.x % bar_ngrp, bar_gsz = gridDim.x / bar_ngrp;
    unsigned my_xcc = 0u, xcc_n = 1u, xcc_pop = 1u;
    if (threadIdx.x == 0) { my_xcc = (unsigned)__builtin_amdgcn_s_getreg((3 << 11) | 20) & 7u;
        __hip_atomic_fetch_add(bar + 640 + 16 * my_xcc, 1u, __ATOMIC_RELAXED, __HIP_MEMORY_SCOPE_AGENT); }
    if (lo < 0) grid.sync();
    if (IN(0)) phase0(p, lds);
    SEAM(0);
    if (IN(1)) {
        pg8::Gemm g{(const bf16_t*)(p.ws + OFF_U) + (size_t)NMETA * DM, (const bf16_t*)(p.ws + OFF_U) + (size_t)NMETA * DM, (const bf16_t*)(p.ws + OFF_WTIN), T, NPROJ, DM, DM, 1 << 20};
        pg8::StaticOrder S; S.init(T, NPROJ, gridDim.x, blockIdx.x);
        pg8::EpiProj E{(bf16_t*)(p.ws + OFF_Z), DM, (bf16_t*)(p.ws + OFF_XC), 4096, NMETA, 1024, nullptr};
        pg8::gemm_phase<pg8::EpiProj>(lds, g, S, E);
        phase1_meta(p);
    }
    SEAM(1);
    if (IN(2)) phase2(p, lds);
    SEAM(2);
    if (IN(3)) phase3(p, lds);
    SEAM(3);
    if (IN(4)) phase4(p);
    SEAM(4);
    if (IN(5)) phase5(p, lds);
    SEAM(5);
    if (IN(6)) {
        pg8::Gemm g{(const bf16_t*)(p.ws + OFF_YSSD), (const bf16_t*)(p.ws + OFF_U), (const bf16_t*)(p.ws + OFF_WTOUT), T, DM, 2048, DM, 16};
        pg8::StaticOrder S; S.init(T, DM, gridDim.x, blockIdx.x);
        pg8::EpiRes E{(float*)(p.ws + OFF_H1), p.x, DM, (bf16_t*)(p.ws + OFF_Z), (float*)(p.ws + OFF_ROWSS)};
        pg8::gemm_phase<pg8::EpiRes>(lds, g, S, E);
    }
    if (IN(6) && IN(8)) { SEAM_BODY(); }
    if (IN(8)) {
        pg8::Gemm g{(const bf16_t*)(p.ws + OFF_Z), (const bf16_t*)(p.ws + OFF_Z), (const bf16_t*)(p.ws + OFF_WTQ), T, 2048, DM, DM, 1 << 20};
        pg8::StaticOrder S; S.init(T, 2048, gridDim.x, blockIdx.x);
        pg8::EpiProj E{(bf16_t*)p.out, 2048, (bf16_t*)p.out, 2048, 0, 1 << 20, (const float*)(p.ws + OFF_ROWSS)};
        pg8::gemm_phase<pg8::EpiProj>(lds, g, S, E);
        phase9(p, lds);
    }
    if (IN(8) && IN(10)) { SEAM_BODY(); }
    if (IN(10)) phase10(p);
#undef IN
#undef SEAM
}

#ifndef MK_MULTI
#define MK_MULTI 0
#endif
extern "C" void kernel_launch(void* const* d_in, const int* in_sizes, int n_in, void* d_out, int out_size, void* d_ws, size_t ws_size, hipStream_t stream) {
    static int grid = 0;
    if (grid == 0) {
        if (n_in != 22 || out_size != T * DM || ws_size < WS_END) { fprintf(stderr, "kernel_launch: unexpected shapes (n_in %d out %d ws %zu need %zu)\n", n_in, out_size, ws_size, (size_t)WS_END); grid = -1; return; }
        int dev = 0, cus = 0, per_cu = 0;
        hipGetDevice(&dev); hipDeviceGetAttribute(&cus, hipDeviceAttributeMultiprocessorCount, dev);
        if (hipFuncSetAttribute((const void*)hymba_fwd, hipFuncAttributeMaxDynamicSharedMemorySize, LDS_BYTES) != hipSuccess) { fprintf(stderr, "kernel_launch: hipFuncSetAttribute failed\n"); grid = -1; return; }
        if (hipOccupancyMaxActiveBlocksPerMultiprocessor(&per_cu, (const void*)hymba_fwd, NTHREADS, LDS_BYTES) != hipSuccess || per_cu < 1) { fprintf(stderr, "kernel_launch: occupancy query gave %d\n", per_cu); per_cu = 1; (void)hipGetLastError(); }
        grid = cus * per_cu;
        fprintf(stderr, "kernel_launch: grid %d (cus %d x %d)\n", grid, cus, per_cu);
    }
    if (grid < 0) return;
    Params p{};
    p.x = (const float*)d_in[0]; p.meta = (const float*)d_in[1]; p.norm_mix_w = (const float*)d_in[2]; p.w_in = (const float*)d_in[3];
    p.ssd_conv_w = (const float*)d_in[4]; p.ssd_conv_b = (const float*)d_in[5]; p.dt_bias = (const float*)d_in[6]; p.A_log = (const float*)d_in[7];
    p.Dskip = (const float*)d_in[8]; p.ssd_norm_w = (const float*)d_in[9]; p.conf_w = (const float*)d_in[10]; p.conf_b = (const float*)d_in[11];
    p.ln_g = (const float*)d_in[12]; p.ln_b = (const float*)d_in[13]; p.w_out = (const float*)d_in[14]; p.norm_ffn_w = (const float*)d_in[15];
    p.w_query = (const float*)d_in[16]; p.keys1 = (const float*)d_in[17]; p.keys2 = (const float*)d_in[18]; p.w_down = (const float*)d_in[19];
    p.w_up = (const float*)d_in[20]; p.norm_final_w = (const float*)d_in[21];
    p.out = (float*)d_out; p.ws = (unsigned char*)d_ws;
#if MK_MULTI
    for (int ph = 0; ph < 11; ++ph) { p.ph_lo = ph; p.ph_hi = ph + 1; hipLaunchKernelGGL(hymba_fwd, dim3(grid), dim3(NTHREADS), LDS_BYTES, stream, p); }
#else
    p.ph_lo = 0; p.ph_hi = 11;
    if (hipMemsetAsync((char*)d_ws + OFF_BAR, 0, 4096, stream) != hipSuccess) fprintf(stderr, "kernel_launch: memset failed\n");
    void* args[] = {&p};
    hipError_t e = hipLaunchCooperativeKernel((const void*)hymba_fwd, dim3(grid), dim3(NTHREADS), args, LDS_BYTES, stream);
    if (e != hipSuccess) fprintf(stderr, "kernel_launch: cooperative launch failed: %s (grid %d)\n", hipGetErrorString(e), grid);
#endif
}
```
